# Optimizing an MI355X kernel written in HIP

```python
import math
import jax, jax.numpy as jnp
from jax import lax
import numpy as np

D_MODEL = 1024
BATCH = 8
SEQ = 4096
DEPTH = 2

HEAD_DIM = 64
N_HEADS_A = 8
N_HEADS_B = 8
N_HEADS = N_HEADS_A + N_HEADS_B
D_MIX = N_HEADS * HEAD_DIM
D_A = N_HEADS_A * HEAD_DIM
D_B = N_HEADS_B * HEAD_DIM
KV_RANK_A = 128
N_KV_A = 2
R_A = N_HEADS_A // N_KV_A
N_IDX_HEADS = 8
IDX_DIM = 64
TOPK_A = 256
N_KV_B = 2
R_B = N_HEADS_B // N_KV_B
D_KV_B = N_KV_B * HEAD_DIM
CMP_BLOCK = 32
CMP_STRIDE = 16
SLC_BLOCK = 64
N_SLC = 16
WINDOW = 512
N_BUCKETS = 32
MAX_DISTANCE = 1024
Q_BLOCK_A = 128
Q_BLOCK_B = 64
EPS = 1e-6
NEG_INF = -1e30
FORCE_BONUS = 1e4
ATTN_SCALE = HEAD_DIM ** -0.5
IDX_SCALE = IDX_DIM ** -0.5
IDX_W_SCALE = N_IDX_HEADS ** -0.5

PROJ_SIZES = (
    D_A, KV_RANK_A, N_IDX_HEADS * IDX_DIM, IDX_DIM, N_IDX_HEADS, D_A,
    D_B, D_KV_B, D_KV_B, D_KV_B, D_KV_B, D_KV_B, D_KV_B, N_HEADS_B * 3, D_B,
)
D_IN = sum(PROJ_SIZES)
PROJ_SPLITS = tuple(int(v) for v in np.cumsum(PROJ_SIZES)[:-1])

kernel_name = 'hybrid_dsa_nsa_parallel_heads'


def rms_norm(x, g):
    xf = x.astype(jnp.float32)
    y = xf * lax.rsqrt(jnp.mean(xf * xf, axis=-1, keepdims=True) + EPS)
    return (y * g.astype(jnp.float32)).astype(x.dtype)


def masked_softmax(logits, mask):
    p = jax.nn.softmax(jnp.where(mask, logits, NEG_INF), axis=-1)
    return jnp.where(mask, p, 0.0)


def t5_bucket(dist):
    n = jnp.maximum(dist, 0)
    max_exact = N_BUCKETS // 2
    nf = jnp.maximum(n, 1).astype(jnp.float32)
    log_b = max_exact + (jnp.log(nf / max_exact) / math.log(MAX_DISTANCE / max_exact)
                         * (N_BUCKETS - max_exact)).astype(jnp.int32)
    return jnp.where(n < max_exact, n, jnp.minimum(log_b, N_BUCKETS - 1))


def band_bias(bias_b, dist):
    return bias_b[t5_bucket(dist)].transpose(0, 2, 3, 1)[None].astype(jnp.float32)


def overlap_map(n_c, n_sb):
    c_start = np.arange(n_c)[:, None] * CMP_STRIDE
    b_start = np.arange(n_sb)[None, :] * SLC_BLOCK
    ov = np.minimum(c_start + CMP_BLOCK, b_start + SLC_BLOCK) - np.maximum(c_start, b_start)
    return (np.maximum(ov, 0) / CMP_BLOCK).astype(np.float32)


def compress(k, pos_emb, w1, w2):
    B, L = k.shape[:2]
    n_c = (L - CMP_BLOCK) // CMP_STRIDE + 1
    idx = np.arange(n_c)[:, None] * CMP_STRIDE + np.arange(CMP_BLOCK)[None, :]
    blocks = k[:, idx] + pos_emb[None, None, :, None, :]
    blocks = blocks.transpose(0, 1, 3, 2, 4).reshape(B, n_c, N_KV_B, CMP_BLOCK * HEAD_DIM)
    return jax.nn.gelu(blocks @ w1) @ w2


def dsa_attention(q, k, v, q_idx, k_idx, w_idx, bias_a):
    B, L = q.shape[:2]
    k_top = min(TOPK_A, L // 4)
    n_qb = L // Q_BLOCK_A
    s_pos = jnp.arange(L)
    b_idx = jnp.arange(B)[:, None, None]

    def block(i):
        q0 = i * Q_BLOCK_A
        t = q0 + jnp.arange(Q_BLOCK_A)
        qa = lax.dynamic_slice_in_dim(q, q0, Q_BLOCK_A, axis=1).reshape(B, Q_BLOCK_A, N_KV_A, R_A, HEAD_DIM)
        qi = lax.dynamic_slice_in_dim(q_idx, q0, Q_BLOCK_A, axis=1)
        wi = lax.dynamic_slice_in_dim(w_idx, q0, Q_BLOCK_A, axis=1).astype(jnp.float32) * IDX_W_SCALE
        dots = jnp.einsum('bqhd,bsd->bqhs', qi, k_idx).astype(jnp.float32) * IDX_SCALE
        score = jnp.einsum('bqh,bqhs->bqs', wi, jax.nn.relu(dots))
        score = jnp.where((s_pos[None, :] <= t[:, None])[None], score, NEG_INF)
        _, sel = lax.top_k(score, k_top)
        k_sel = k[b_idx, sel]
        v_sel = v[b_idx, sel]
        dist = t[None, :, None] - sel
        logits = jnp.einsum('bqgrd,bqkgd->bqgrk', qa, k_sel).astype(jnp.float32) * ATTN_SCALE
        bias = bias_a[t5_bucket(dist)].reshape(B, Q_BLOCK_A, k_top, N_KV_A, R_A).transpose(0, 1, 3, 4, 2)
        p = masked_softmax(logits + bias.astype(jnp.float32), (dist >= 0)[:, :, None, None, :])
        o = jnp.einsum('bqgrk,bqkgd->bqgrd', p.astype(v_sel.dtype), v_sel)
        return o.reshape(B, Q_BLOCK_A, D_A)

    out = lax.map(block, jnp.arange(n_qb))
    return out.transpose(1, 0, 2, 3).reshape(B, L, D_A)


def nsa_attention(q, k_c, v_c, k_s, v_s, k_w, v_w, gates, bias_b):
    B, L = q.shape[:2]
    n_c = k_c.shape[1]
    n_sb = L // SLC_BLOCK
    n_sel = min(N_SLC, n_sb)
    n_qb = L // Q_BLOCK_B
    end_c = jnp.asarray(np.arange(n_c) * CMP_STRIDE + CMP_BLOCK - 1)
    slc_map = jnp.asarray(overlap_map(n_c, n_sb))
    blk = jnp.arange(n_sb)
    ks_blk = k_s.reshape(B, n_sb, SLC_BLOCK, N_KV_B, HEAD_DIM).transpose(0, 3, 1, 2, 4)
    vs_blk = v_s.reshape(B, n_sb, SLC_BLOCK, N_KV_B, HEAD_DIM).transpose(0, 3, 1, 2, 4)
    pad = ((0, 0), (WINDOW, 0), (0, 0), (0, 0))
    kw_pad = jnp.pad(k_w, pad)
    vw_pad = jnp.pad(v_w, pad)
    b_i = jnp.arange(B)[:, None, None, None]
    g_i = jnp.arange(N_KV_B)[None, None, :, None]
    in_blk = jnp.arange(SLC_BLOCK)
    n_tok = n_sel * SLC_BLOCK

    def block(i):
        q0 = i * Q_BLOCK_B
        t = q0 + jnp.arange(Q_BLOCK_B)
        qb = lax.dynamic_slice_in_dim(q, q0, Q_BLOCK_B, axis=1).reshape(B, Q_BLOCK_B, N_KV_B, R_B, HEAD_DIM)
        gb = lax.dynamic_slice_in_dim(gates, q0, Q_BLOCK_B, axis=1).reshape(B, Q_BLOCK_B, N_KV_B, R_B, 3)
        dist_c = t[:, None] - end_c[None, :]
        logits_c = jnp.einsum('bqgrd,bcgd->bqgrc', qb, k_c).astype(jnp.float32) * ATTN_SCALE
        p_c = masked_softmax(logits_c + band_bias(bias_b, dist_c), (dist_c >= 0)[None, :, None, None, :])
        o_c = jnp.einsum('bqgrc,bcgd->bqgrd', p_c.astype(v_c.dtype), v_c)
        imp = jnp.einsum('bqgrc,cn->bqgn', p_c, slc_map)
        jt = t // SLC_BLOCK
        forced = (blk[None, :] == 0) | (blk[None, :] == jt[:, None]) | (blk[None, :] == jt[:, None] - 1)
        imp = imp + jnp.where(forced, FORCE_BONUS, 0.0)[None, :, None, :]
        imp = jnp.where((blk[None, :] * SLC_BLOCK <= t[:, None])[None, :, None, :], imp, NEG_INF)
        _, sel = lax.top_k(imp, n_sel)
        k_sel = ks_blk[b_i, g_i, sel].reshape(B, Q_BLOCK_B, N_KV_B, n_tok, HEAD_DIM)
        v_sel = vs_blk[b_i, g_i, sel].reshape(B, Q_BLOCK_B, N_KV_B, n_tok, HEAD_DIM)
        pos = (sel[..., None] * SLC_BLOCK + in_blk).reshape(B, Q_BLOCK_B, N_KV_B, n_tok)
        dist_s = t[None, :, None, None] - pos
        logits_s = jnp.einsum('bqgrd,bqgnd->bqgrn', qb, k_sel).astype(jnp.float32) * ATTN_SCALE
        bias_s = bias_b[t5_bucket(dist_s), g_i].transpose(0, 1, 2, 4, 3)
        p_s = masked_softmax(logits_s + bias_s.astype(jnp.float32), (dist_s >= 0)[:, :, :, None, :])
        o_s = jnp.einsum('bqgrn,bqgnd->bqgrd', p_s.astype(v_sel.dtype), v_sel)
        s = q0 - WINDOW + jnp.arange(WINDOW + Q_BLOCK_B)
        kw = lax.dynamic_slice_in_dim(kw_pad, q0, WINDOW + Q_BLOCK_B, axis=1)
        vw = lax.dynamic_slice_in_dim(vw_pad, q0, WINDOW + Q_BLOCK_B, axis=1)
        dist_w = t[:, None] - s[None, :]
        mask_w = (dist_w >= 0) & (dist_w < WINDOW) & (s[None, :] >= 0)
        logits_w = jnp.einsum('bqgrd,bsgd->bqgrs', qb, kw).astype(jnp.float32) * ATTN_SCALE
        p_w = masked_softmax(logits_w + band_bias(bias_b, dist_w), mask_w[None, :, None, None, :])
        o_w = jnp.einsum('bqgrs,bsgd->bqgrd', p_w.astype(vw.dtype), vw)
        o = gb[..., 0:1] * o_c + gb[..., 1:2] * o_s + gb[..., 2:3] * o_w
        return o.reshape(B, Q_BLOCK_B, D_B)

    out = lax.map(block, jnp.arange(n_qb))
    return out.transpose(1, 0, 2, 3).reshape(B, L, D_B)


def setup_inputs(seed: int = 0) -> dict:
    key = jax.random.key(seed)
    ks = jax.random.split(key, 24)
    f32 = jnp.float32

    def nrm(k, shape, scale):
        return jax.random.normal(k, shape, f32) * scale

    def gain(k, shape):
        return 1.0 + 0.01 * jax.random.normal(k, shape, f32)

    return {
        'x': nrm(ks[0], (BATCH, SEQ, D_MODEL), 1.0),
        'rel_bias': nrm(ks[1], (N_BUCKETS, N_HEADS), 0.5),
        'norm_g': gain(ks[2], (DEPTH, D_MODEL)),
        'w_in': nrm(ks[3], (DEPTH, D_MODEL, D_IN), D_MODEL ** -0.5),
        'b_gate_b': nrm(ks[4], (DEPTH, N_HEADS_B * 3), 0.1),
        'kv_norm_a': gain(ks[5], (DEPTH, KV_RANK_A)),
        'w_kv_up_a': nrm(ks[6], (DEPTH, KV_RANK_A, 2 * N_KV_A * HEAD_DIM), KV_RANK_A ** -0.5),
        'q_norm_a': gain(ks[7], (DEPTH, HEAD_DIM)),
        'k_norm_a': gain(ks[8], (DEPTH, HEAD_DIM)),
        'q_norm_b': gain(ks[9], (DEPTH, HEAD_DIM)),
        'k_norm_cmp': gain(ks[10], (DEPTH, HEAD_DIM)),
        'k_norm_slc': gain(ks[11], (DEPTH, HEAD_DIM)),
        'k_norm_win': gain(ks[12], (DEPTH, HEAD_DIM)),
        'cmp_pos_k': nrm(ks[13], (DEPTH, CMP_BLOCK, HEAD_DIM), 0.2),
        'cmp_pos_v': nrm(ks[14], (DEPTH, CMP_BLOCK, HEAD_DIM), 0.2),
        'w_cmp_k1': nrm(ks[15], (DEPTH, CMP_BLOCK * HEAD_DIM, HEAD_DIM), (CMP_BLOCK * HEAD_DIM) ** -0.5),
        'w_cmp_k2': nrm(ks[16], (DEPTH, HEAD_DIM, HEAD_DIM), HEAD_DIM ** -0.5),
        'w_cmp_v1': nrm(ks[17], (DEPTH, CMP_BLOCK * HEAD_DIM, HEAD_DIM), (CMP_BLOCK * HEAD_DIM) ** -0.5),
        'w_cmp_v2': nrm(ks[18], (DEPTH, HEAD_DIM, HEAD_DIM), HEAD_DIM ** -0.5),
        'w_out': nrm(ks[19], (DEPTH, D_MIX, D_MODEL), D_MIX ** -0.5),
    }


def reference(x, rel_bias, norm_g, w_in, b_gate_b, kv_norm_a, w_kv_up_a, q_norm_a, k_norm_a,
              q_norm_b, k_norm_cmp, k_norm_slc, k_norm_win, cmp_pos_k, cmp_pos_v,
              w_cmp_k1, w_cmp_k2, w_cmp_v1, w_cmp_v2, w_out):
    B, L, _ = x.shape
    bias_a = rel_bias[:, :N_HEADS_A]
    bias_b = rel_bias[:, N_HEADS_A:].reshape(N_BUCKETS, N_KV_B, R_B)
    kv_shape = (B, L, N_KV_B, HEAD_DIM)
    for l in range(DEPTH):
        h = rms_norm(x, norm_g[l])
        proj = h @ w_in[l]
        (q_a, c_kv, q_idx, k_idx, w_idx, z_a,
         q_b, k_cmp, v_cmp, k_slc, v_slc, k_win, v_win, g_b, z_b) = jnp.split(proj, PROJ_SPLITS, axis=-1)
        q_a = rms_norm(q_a.reshape(B, L, N_HEADS_A, HEAD_DIM), q_norm_a[l])
        kv_a = (rms_norm(c_kv, kv_norm_a[l]) @ w_kv_up_a[l]).reshape(B, L, 2 * N_KV_A, HEAD_DIM)
        k_a, v_a = jnp.split(kv_a, 2, axis=2)
        k_a = rms_norm(k_a, k_norm_a[l])
        o_a = dsa_attention(q_a, k_a, v_a, q_idx.reshape(B, L, N_IDX_HEADS, IDX_DIM), k_idx, w_idx, bias_a)
        q_b = rms_norm(q_b.reshape(B, L, N_HEADS_B, HEAD_DIM), q_norm_b[l])
        k_c = rms_norm(compress(k_cmp.reshape(kv_shape), cmp_pos_k[l], w_cmp_k1[l], w_cmp_k2[l]), k_norm_cmp[l])
        v_c = compress(v_cmp.reshape(kv_shape), cmp_pos_v[l], w_cmp_v1[l], w_cmp_v2[l])
        k_s = rms_norm(k_slc.reshape(kv_shape), k_norm_slc[l])
        k_w = rms_norm(k_win.reshape(kv_shape), k_norm_win[l])
        gates = jax.nn.sigmoid((g_b + b_gate_b[l]).astype(jnp.float32)).astype(x.dtype).reshape(B, L, N_HEADS_B, 3)
        o_b = nsa_attention(q_b, k_c, v_c, k_s, v_slc.reshape(kv_shape), k_w, v_win.reshape(kv_shape), gates, bias_b)
        y = jnp.concatenate([o_a * jax.nn.silu(z_a), o_b * jax.nn.silu(z_b)], axis=-1)
        x = x + y @ w_out[l]
    return x
```

```cpp
#include <hip/hip_runtime.h>
#include <hip/hip_cooperative_groups.h>
#include <stdint.h>
#include <stdio.h>
namespace cg = cooperative_groups;

#ifndef MEGA
#define MEGA 1
#endif
#ifndef NAIVE_NSA
#define NAIVE_NSA 0
#endif
#ifndef NAIVE_DSA
#define NAIVE_DSA 0
#endif
#ifndef NAIVE_P2
#define NAIVE_P2 0
#endif
#ifndef NAIVE_GEMM
#define NAIVE_GEMM 0
#endif

typedef unsigned short bf16_t;
typedef unsigned long long u64;
#define DEV __device__ __forceinline__

constexpr int NBATCH = 8, SEQ = 4096, DM = 1024, NTOK = NBATCH * SEQ, DIN = 3552, DP = 3584;
constexpr int NTHREADS = 512, NWAVES = 8;
constexpr int C_QA = 0, C_QI = 512, C_ZA = 1024, C_QB = 1536, C_ZB = 2048, C_CKV = 2560, C_KI = 2688, C_WI = 2752, C_GB = 2760,
              C_KC = 2816, C_VC = 2944, C_KS = 3072, C_VS = 3200, C_KW = 3328, C_VW = 3456;
constexpr float EPS = 1e-6f;
constexpr int LDS_BYTES = 152 * 1024;

struct Params;
typedef const __attribute__((address_space(4))) Params& CP;
struct Params {
    const float *x, *rel_bias, *norm_g, *w_in, *b_gate_b, *kv_norm_a, *w_kv_up_a, *q_norm_a, *k_norm_a, *q_norm_b, *k_norm_cmp, *k_norm_slc,
        *k_norm_win, *cmp_pos_k, *cmp_pos_v, *w_cmp_k1, *w_cmp_k2, *w_cmp_v1, *w_cmp_v2, *w_out;
    float* out;
    bf16_t *wt_in, *wt_out, *wt_kvup, *wt_c1k, *wt_c1v, *wt_c2k, *wt_c2v;
    float *cbias_k, *cbias_v, *biasd;
    bf16_t *H, *P, *Ka, *Va, *Kc, *Vc;
    unsigned* ctrl;
    float* out2; unsigned long long* chk;
    bf16_t* x1b;
    float* ssq;
    bf16_t *Ki, *Ks, *Vs, *Kw, *Vw;
};

typedef float f32x2_t __attribute__((ext_vector_type(2)));
typedef __bf16 bf16x2_t __attribute__((ext_vector_type(2)));
DEV unsigned cvt_pk_rne(float lo, float hi) { f32x2_t v = {lo, hi}; bf16x2_t b = __builtin_convertvector(v, bf16x2_t); return __builtin_bit_cast(unsigned, b); }
DEV int tidx() { int t = (int)__builtin_amdgcn_workitem_id_x(); asm volatile("" : "+v"(t)); return t; }
DEV float bf2f(bf16_t v) { return __uint_as_float(((unsigned)v) << 16); }
DEV bf16_t f2bf(float f) { unsigned u = __float_as_uint(f); u += 0x7FFFu + ((u >> 16) & 1u); return (bf16_t)(u >> 16); }
DEV unsigned pk2(float lo, float hi) { return (unsigned)f2bf(lo) | ((unsigned)f2bf(hi) << 16); }
DEV void unpack8g(const uint4 v, float (&x)[8]) {
    x[0] = __uint_as_float(v.x << 16); x[1] = __uint_as_float(v.x & 0xFFFF0000u); x[2] = __uint_as_float(v.y << 16); x[3] = __uint_as_float(v.y & 0xFFFF0000u);
    x[4] = __uint_as_float(v.z << 16); x[5] = __uint_as_float(v.z & 0xFFFF0000u); x[6] = __uint_as_float(v.w << 16); x[7] = __uint_as_float(v.w & 0xFFFF0000u);
}
DEV float wave_sum(float v) {
#pragma unroll
    for (int o = 1; o < 64; o <<= 1) v += __shfl_xor(v, o);
    return v;
}
DEV float wave_max(float v) {
#pragma unroll
    for (int o = 1; o < 64; o <<= 1) v = fmaxf(v, __shfl_xor(v, o));
    return v;
}
DEV int wave_sum_i(int v) {
#pragma unroll
    for (int o = 1; o < 64; o <<= 1) v += __shfl_xor(v, o);
    return v;
}
DEV unsigned f2key(float f) { unsigned u = __float_as_uint(f); return (u & 0x80000000u) ? ~u : (u | 0x80000000u); }
DEV float silu(float z) { return z * __builtin_amdgcn_rcpf(1.f + __expf(-z)); }
DEV float sigmoidf_(float z) { return __builtin_amdgcn_rcpf(1.f + __expf(-z)); }
DEV float gelu_tanh(float x) { const float y = 0.7978845608028654f * (x + 0.044715f * x * x * x); const float t = 1.f - 2.f * __builtin_amdgcn_rcpf(__expf(2.f * y) + 1.f); return 0.5f * x * (1.f + t); }
DEV int t5_bucket(int d) {
    if (d < 16) return d < 0 ? 0 : d;
    int b = 16;
    b += (d >= 21); b += (d >= 27); b += (d >= 35); b += (d >= 46); b += (d >= 59); b += (d >= 77); b += (d >= 99); b += (d >= 128);
    b += (d >= 166); b += (d >= 216); b += (d >= 280); b += (d >= 363); b += (d >= 470); b += (d >= 609); b += (d >= 790);
    return b;
}
DEV int src_col(int n) {
    if (n < 512) return n;
    if (n < 1024) return 640 + (n - 512);
    if (n < 1536) return 1224 + (n - 1024);
    if (n < 2048) return 1736 + (n - 1536);
    if (n < 2560) return 3040 + (n - 2048);
    if (n < 2688) return 512 + (n - 2560);
    if (n < 2752) return 1152 + (n - 2688);
    if (n < 2760) return 1216 + (n - 2752);
    if (n < 2784) return 3016 + (n - 2760);
    if (n < 2816) return -1;
    return 2248 + (n - 2816);
}
DEV float dot64(const bf16_t* __restrict__ row, const float* q) {
    float acc = 0.f;
#pragma unroll
    for (int c = 0; c < 8; ++c) {
        const uint4 v = *(const uint4*)(row + c * 8);
        const unsigned w[4] = {v.x, v.y, v.z, v.w};
#pragma unroll
        for (int j = 0; j < 4; ++j) { acc = fmaf(__uint_as_float(w[j] << 16), q[c * 8 + 2 * j], acc); acc = fmaf(__uint_as_float(w[j] & 0xFFFF0000u), q[c * 8 + 2 * j + 1], acc); }
    }
    return acc;
}

struct TileDesc { const float* src; int Nsrc; bf16_t* dst; int K, k0, n0; bool colmap; const float* kscale; };
DEV void transpose_pair(const TileDesc& A, const TileDesc& B, bool hasB, float* tile  ) {
    const int tid = tidx();
    {
        const int nn = tid & 63, kk0 = tid >> 6;
        int scA = A.n0 + nn; if (A.colmap) scA = src_col(scA);
        int scB = B.n0 + nn; if (B.colmap) scB = src_col(scB);
        const float* spA = A.src + (size_t)(A.k0 + kk0) * A.Nsrc + max(scA, 0);
        const float* spB = B.src + (size_t)(B.k0 + kk0) * B.Nsrc + max(scB, 0);
        float va[8], vb[8];
#pragma unroll
        for (int i = 0; i < 8; ++i) va[i] = spA[(size_t)(8 * i) * A.Nsrc];
#pragma unroll
        for (int i = 0; i < 8; ++i) vb[i] = spB[(size_t)(8 * i) * B.Nsrc];
#pragma unroll
        for (int i = 0; i < 8; ++i) tile[(kk0 + 8 * i) * 65 + nn] = (scA >= 0) ? (A.kscale ? va[i] * A.kscale[A.k0 + kk0 + 8 * i] : va[i]) : 0.f;
#pragma unroll
        for (int i = 0; i < 8; ++i) tile[64 * 65 + (kk0 + 8 * i) * 65 + nn] = (scB >= 0) ? (B.kscale ? vb[i] * B.kscale[B.k0 + kk0 + 8 * i] : vb[i]) : 0.f;
    }
    __syncthreads();
    {
        const int nn = tid >> 3, kg = tid & 7;
#pragma unroll
        for (int h = 0; h < 2; ++h) {
            const float* tl = tile + h * 64 * 65;
            uint4 o;
            o.x = pk2(tl[(8 * kg + 0) * 65 + nn], tl[(8 * kg + 1) * 65 + nn]); o.y = pk2(tl[(8 * kg + 2) * 65 + nn], tl[(8 * kg + 3) * 65 + nn]);
            o.z = pk2(tl[(8 * kg + 4) * 65 + nn], tl[(8 * kg + 5) * 65 + nn]); o.w = pk2(tl[(8 * kg + 6) * 65 + nn], tl[(8 * kg + 7) * 65 + nn]);
            const TileDesc& D = h ? B : A;
            if (h == 0 || hasB) *(uint4*)(D.dst + (size_t)(D.n0 + nn) * D.K + D.k0 + 8 * kg) = o;
        }
    }
    __syncthreads();
}
DEV void rms_row_to_bf16(const float* __restrict__ xrow, const float* __restrict__ g, bf16_t* __restrict__ orow, int lane) {
    float4 v[4]; float s = 0.f;
#pragma unroll
    for (int j = 0; j < 4; ++j) { v[j] = ((const float4*)xrow)[lane + 64 * j]; s += v[j].x * v[j].x + v[j].y * v[j].y + v[j].z * v[j].z + v[j].w * v[j].w; }
    const float r = rsqrtf(wave_sum(s) * (1.f / DM) + EPS);
#pragma unroll
    for (int j = 0; j < 4; ++j) {
        const float4 gg = ((const float4*)g)[lane + 64 * j];
        uint2 o; o.x = pk2(v[j].x * r * gg.x, v[j].y * r * gg.y); o.y = pk2(v[j].z * r * gg.z, v[j].w * r * gg.w);
        ((uint2*)orow)[lane + 64 * j] = o;
    }
}
DEV void rms_rowb_to_bf16(const bf16_t* __restrict__ xrow, const float* __restrict__ g, bf16_t* __restrict__ orow, int lane) {
    float v[2][8]; float s = 0.f;
#pragma unroll
    for (int j = 0; j < 2; ++j) { unpack8g(((const uint4*)xrow)[lane + 64 * j], v[j]);
#pragma unroll
        for (int e = 0; e < 8; ++e) s = fmaf(v[j][e], v[j][e], s); }
    const float r = rsqrtf(wave_sum(s) * (1.f / DM) + EPS);
#pragma unroll
    for (int j = 0; j < 2; ++j) {
        const float4 g0 = ((const float4*)g)[2 * (lane + 64 * j)], g1 = ((const float4*)g)[2 * (lane + 64 * j) + 1];
        uint4 o; o.x = pk2(v[j][0] * r * g0.x, v[j][1] * r * g0.y); o.y = pk2(v[j][2] * r * g0.z, v[j][3] * r * g0.w); o.z = pk2(v[j][4] * r * g1.x, v[j][5] * r * g1.y); o.w = pk2(v[j][6] * r * g1.z, v[j][7] * r * g1.w);
        ((uint4*)orow)[lane + 64 * j] = o;
    }
}
DEV void phase_norm_hb(CP p, int layer, int bid, int nb) {
    const int wid = tidx() >> 6, lane = tidx() & 63;
    for (int row = bid * NWAVES + wid; row < NTOK; row += nb * NWAVES) rms_rowb_to_bf16(p.x1b + (size_t)row * DM, p.norm_g + layer * DM, p.H + (size_t)row * DM, lane);
}
DEV float wave_sum_fast(float v) {
    v += __int_as_float(__builtin_amdgcn_update_dpp(0, __float_as_int(v), 0xB1, 0xF, 0xF, true));
    v += __int_as_float(__builtin_amdgcn_update_dpp(0, __float_as_int(v), 0x4E, 0xF, 0xF, true));
    v += __int_as_float(__builtin_amdgcn_update_dpp(0, __float_as_int(v), 0x141, 0xF, 0xF, true));
    v += __int_as_float(__builtin_amdgcn_update_dpp(0, __float_as_int(v), 0x140, 0xF, 0xF, true));
    const int iv = __float_as_int(v);
    return (__int_as_float(__builtin_amdgcn_readlane(iv, 0)) + __int_as_float(__builtin_amdgcn_readlane(iv, 16))) + (__int_as_float(__builtin_amdgcn_readlane(iv, 32)) + __int_as_float(__builtin_amdgcn_readlane(iv, 48)));
}
DEV void phase_norm_h(CP p, const float* __restrict__ src, int layer, int bid, int nb) {
    const int wid = tidx() >> 6, lane = tidx() & 63;
    const float* g = p.norm_g + layer * DM;
    float4 gg[4];
#pragma unroll
    for (int j = 0; j < 4; ++j) gg[j] = ((const float4*)g)[lane + 64 * j];
    const int stride = nb * NWAVES;
    for (int row = bid * NWAVES + wid; row < NTOK; row += 4 * stride) {
        float4 v[4][4];
#pragma unroll
        for (int q = 0; q < 4; ++q) { const float* xr = src + (size_t)min(row + q * stride, NTOK - 1) * DM;
#pragma unroll
            for (int j = 0; j < 4; ++j) v[q][j] = ((const float4*)xr)[lane + 64 * j]; }
#pragma unroll
        for (int q = 0; q < 4; ++q) {
            float s = 0.f;
#pragma unroll
            for (int j = 0; j < 4; ++j) s += v[q][j].x * v[q][j].x + v[q][j].y * v[q][j].y + v[q][j].z * v[q][j].z + v[q][j].w * v[q][j].w;
            const float r = rsqrtf(wave_sum_fast(s) * (1.f / DM) + EPS);
            if (row + q * stride < NTOK) {
                bf16_t* orow = p.H + (size_t)(row + q * stride) * DM;
#pragma unroll
                for (int j = 0; j < 4; ++j) { uint2 o; o.x = pk2(v[q][j].x * r * gg[j].x, v[q][j].y * r * gg[j].y); o.y = pk2(v[q][j].z * r * gg[j].z, v[q][j].w * r * gg[j].w); ((uint2*)orow)[lane + 64 * j] = o; }
            }
        }
    }
}
DEV void phase0_prep(CP p, int bid, int nb, char* lds) {
    float* tile = (float*)lds;
    const int tid = tidx();
    constexpr int T_IN = (DP / 64) * (DM / 64), T_OUT = 16 * 16, T_KV = 2 * 4, T_C1 = 32, T_C2 = 1, T_L = T_IN + T_OUT + T_KV + 2 * T_C1 + 2 * T_C2;
    auto desc = [&](int it) -> TileDesc {
        const int l = it / T_L; int r = it % T_L;
        if (r < T_IN) { const int nt = r / (DM / 64), kt = r % (DM / 64); return TileDesc{p.w_in + (size_t)l * DM * DIN, DIN, p.wt_in + (size_t)l * DP * DM, DM, kt * 64, nt * 64, true, l == 1 ? p.norm_g + DM : nullptr}; } r -= T_IN;
        if (r < T_OUT) { const int nt = r / 16, kt = r % 16; return TileDesc{p.w_out + (size_t)l * DM * DM, DM, p.wt_out + (size_t)l * DM * DM, DM, kt * 64, nt * 64, false, nullptr}; } r -= T_OUT;
        if (r < T_KV) { const int nt = r / 2, kt = r % 2; return TileDesc{p.w_kv_up_a + (size_t)l * 128 * 256, 256, p.wt_kvup + (size_t)l * 256 * 128, 128, kt * 64, nt * 64, false, nullptr}; } r -= T_KV;
        if (r < T_C1) return TileDesc{p.w_cmp_k1 + (size_t)l * 2048 * 64, 64, p.wt_c1k + (size_t)l * 64 * 2048, 2048, r * 64, 0, false, nullptr}; r -= T_C1;
        if (r < T_C1) return TileDesc{p.w_cmp_v1 + (size_t)l * 2048 * 64, 64, p.wt_c1v + (size_t)l * 64 * 2048, 2048, r * 64, 0, false, nullptr}; r -= T_C1;
        if (r < T_C2) return TileDesc{p.w_cmp_k2 + (size_t)l * 64 * 64, 64, p.wt_c2k + (size_t)l * 64 * 64, 64, 0, 0, false, nullptr};
        return TileDesc{p.w_cmp_v2 + (size_t)l * 64 * 64, 64, p.wt_c2v + (size_t)l * 64 * 64, 64, 0, 0, false, nullptr};
    };
    for (int it = bid; it < 2 * T_L; it += 2 * nb) {
        const bool hasB = it + nb < 2 * T_L;
        const TileDesc A = desc(it), B = desc(hasB ? it + nb : it);
        transpose_pair(A, B, hasB, tile);
    }
    for (int it = bid; it < 32; it += nb) {
        const int l = it >> 4, kv = (it >> 3) & 1, n0 = (it & 7) * 8;
        const float* pos = (kv ? p.cmp_pos_v : p.cmp_pos_k) + (size_t)l * 2048;
        const float* w1 = (kv ? p.w_cmp_v1 : p.w_cmp_k1) + (size_t)l * 2048 * 64;
        const int n = tid & 7, part = tid >> 3;
        float wv[32], pv[32];
#pragma unroll
        for (int i = 0; i < 32; ++i) { wv[i] = w1[(size_t)(part * 32 + i) * 64 + n0 + n]; pv[i] = pos[part * 32 + i]; }
        float acc = 0.f;
#pragma unroll
        for (int i = 0; i < 32; ++i) acc = fmaf(pv[i], wv[i], acc);
        tile[part * 8 + n] = acc;
        __syncthreads();
        if (tid < 8) { float s = 0.f; for (int q = 0; q < 64; ++q) s += tile[q * 8 + tid]; (kv ? p.cbias_v : p.cbias_k)[l * 64 + n0 + tid] = s; }
        __syncthreads();
    }
    for (int e = bid * NTHREADS + tid; e < 16 * 1024; e += nb * NTHREADS) { const int h = e >> 10, d = e & 1023; p.biasd[e] = p.rel_bias[t5_bucket(d) * 16 + h]; }
    phase_norm_h(p, p.x, 0, bid, nb);
}

template <int MODE  >
DEV void phase_gemm_naive(const bf16_t* __restrict__ A, const bf16_t* __restrict__ Bt, int N, bf16_t* __restrict__ Pout, const float* resid, float* out, int bid, int nb) {
    const size_t total = (size_t)NTOK * N;
    for (size_t e = (size_t)bid * NTHREADS + tidx(); e < total; e += (size_t)nb * NTHREADS) {
        const int t = (int)(e / N), n = (int)(e % N);
        const uint4* a = (const uint4*)(A + (size_t)t * DM); const uint4* b = (const uint4*)(Bt + (size_t)n * DM);
        float acc = 0.f;
        for (int c = 0; c < DM / 8; ++c) {
            const uint4 av = a[c], bv = b[c];
            const unsigned aw[4] = {av.x, av.y, av.z, av.w}, bw[4] = {bv.x, bv.y, bv.z, bv.w};
#pragma unroll
            for (int j = 0; j < 4; ++j) { acc = fmaf(__uint_as_float(aw[j] << 16), __uint_as_float(bw[j] << 16), acc); acc = fmaf(__uint_as_float(aw[j] & 0xFFFF0000u), __uint_as_float(bw[j] & 0xFFFF0000u), acc); }
        }
        if (MODE == 0) Pout[e] = f2bf(acc); else out[e] = resid[e] + acc;
    }
}


namespace pg8 {
#define PG8_LAS __attribute__((address_space(3)))
typedef short bf16x8 __attribute__((ext_vector_type(8)));
typedef float f32x4 __attribute__((ext_vector_type(4)));
typedef unsigned u32x4 __attribute__((ext_vector_type(4)));
constexpr int BM = 256, BK = 64, HALF = 128, HTB = HALF * BK * 2, STAGE_BYTES = 8 * HTB, NXCD = 8, WGM = 8;
DEV int lds_byte(int r, int c) { const int st = (r >> 4) * 2 + (c >> 5), rr = r & 15, cc = c & 31, ob = rr * 64 + cc * 2; return st * 1024 + (ob ^ (((ob >> 9) & 1) << 5)); }
DEV void stage_rc(int b, int& R, int& C) { const int st = b / 1024, sb = b % 1024, swz = sb ^ (((sb >> 9) & 1) << 5); R = (st >> 1) * 16 + swz / 64; C = (st & 1) * 32 + (swz % 64) / 2; }
DEV int perm32(int rho) { const int n = rho >> 4, i = rho & 15; return 8 * (i >> 2) + 4 * n + (i & 3); }
struct Unit { int pm, pn; };
struct Gemm { const bf16_t* A; const bf16_t* Bt; int M, N, K; };
struct StaticOrder {
    int nM, nN, nwg, G, c;
    DEV void init(int M, int N, int G_, int c_) { nM = M / BM; nN = N / BM; nwg = nM * nN; G = G_; c = c_; }
    DEV bool next(int i, Unit& u) const {
        const long L = (long)i * G + c; if (L >= nwg) return false;
        int wgid = (int)L; { const int q = nwg / NXCD, r = nwg % NXCD, xcd = wgid % NXCD, off = wgid / NXCD; wgid = (xcd < r ? xcd * (q + 1) : r * (q + 1) + (xcd - r) * q) + off; }
        const int nig = WGM * nN, gid = wgid / nig, fm = gid * WGM, gsz = (nM - fm) < WGM ? (nM - fm) : WGM;
        u.pm = fm + ((wgid % nig) % gsz); u.pn = (wgid % nig) / gsz; return true;
    }
};
DEV unsigned cvt_pk_bf16(float lo, float hi) { return cvt_pk_rne(lo, hi); }
struct EpiBf16 {
    static constexpr bool PERM = true, INIT_LOAD = false;
    DEV void load(f32x4 (&)[2][2][4][2], const Unit&, int, int, int, int) const {}
    bf16_t* O; int ldc;
    DEV void operator()(const f32x4 (&acc)[2][2][4][2], const Unit& u, int wr, int wc, int fr, int fq) const {
        const int row0 = u.pm * BM + wr * 64 + fr, col0 = u.pn * BM + wc * 32 + 8 * fq;
#pragma unroll
        for (int ai = 0; ai < 2; ++ai)
#pragma unroll
            for (int m = 0; m < 4; ++m) { bf16_t* rowp = O + (size_t)(row0 + ai * HALF + m * 16) * ldc + col0;
#pragma unroll
                for (int bj = 0; bj < 2; ++bj) { const f32x4 v0 = acc[ai][bj][m][0], v1 = acc[ai][bj][m][1];
                    u32x4 w; w.x = cvt_pk_bf16(v0[0], v0[1]); w.y = cvt_pk_bf16(v0[2], v0[3]); w.z = cvt_pk_bf16(v1[0], v1[1]); w.w = cvt_pk_bf16(v1[2], v1[3]);
                    *(u32x4*)(rowp + bj * HALF) = w; } }
    }
};
struct EpiResF32 {
    static constexpr bool PERM = false, INIT_LOAD = true;
    const float* R; float* C; int ldc;
    DEV void load(f32x4 (&acc)[2][2][4][2], const Unit& u, int wr, int wc, int fr, int fq) const {
        const int row0 = u.pm * BM + wr * 64 + fr, col0 = u.pn * BM + wc * 32 + 4 * fq;
#pragma unroll
        for (int ai = 0; ai < 2; ++ai)
#pragma unroll
            for (int m = 0; m < 4; ++m) { const size_t ro = (size_t)(row0 + ai * HALF + m * 16) * ldc + col0;
#pragma unroll
                for (int bj = 0; bj < 2; ++bj)
#pragma unroll
                    for (int n = 0; n < 2; ++n) acc[ai][bj][m][n] = *(const f32x4*)(R + ro + bj * HALF + n * 16); }
    }
    DEV void operator()(const f32x4 (&acc)[2][2][4][2], const Unit& u, int wr, int wc, int fr, int fq) const {
        const int row0 = u.pm * BM + wr * 64 + fr, col0 = u.pn * BM + wc * 32 + 4 * fq;
#pragma unroll
        for (int ai = 0; ai < 2; ++ai)
#pragma unroll
            for (int m = 0; m < 4; ++m) { const size_t ro = (size_t)(row0 + ai * HALF + m * 16) * ldc + col0;
#pragma unroll
                for (int bj = 0; bj < 2; ++bj)
#pragma unroll
                    for (int n = 0; n < 2; ++n) *(f32x4*)(C + ro + bj * HALF + n * 16) = acc[ai][bj][m][n]; }
    }
};
struct EpiBf16S {
    static constexpr bool PERM = true, INIT_LOAD = false;
    DEV void load(f32x4 (&)[2][2][4][2], const Unit&, int, int, int, int) const {}
    bf16_t* O; int ldc; const PG8_LAS float* rtab; mutable int k;
    DEV void operator()(const f32x4 (&acc)[2][2][4][2], const Unit& u, int wr, int wc, int fr, int fq) const {
        const int row0 = u.pm * BM + wr * 64 + fr, col0 = u.pn * BM + wc * 32 + 8 * fq;
        const PG8_LAS float* rt = rtab + k * BM + wr * 64 + fr; ++k;
#pragma unroll
        for (int ai = 0; ai < 2; ++ai)
#pragma unroll
            for (int m = 0; m < 4; ++m) { bf16_t* rowp = O + (size_t)(row0 + ai * HALF + m * 16) * ldc + col0; const float r = rt[ai * HALF + m * 16];
#pragma unroll
                for (int bj = 0; bj < 2; ++bj) { const f32x4 v0 = acc[ai][bj][m][0], v1 = acc[ai][bj][m][1];
                    u32x4 w; w.x = cvt_pk_bf16(v0[0] * r, v0[1] * r); w.y = cvt_pk_bf16(v0[2] * r, v0[3] * r); w.z = cvt_pk_bf16(v1[0] * r, v1[1] * r); w.w = cvt_pk_bf16(v1[2] * r, v1[3] * r);
                    *(u32x4*)(rowp + bj * HALF) = w; } }
    }
};
template <bool RB, bool OB>
struct EpiRes {
    static constexpr bool PERM = true, INIT_LOAD = true;
    const float* Rf; const bf16_t* Rb; float* Cf; bf16_t* Cb; int ldc; float* ssq;
    DEV void load(f32x4 (&acc)[2][2][4][2], const Unit& u, int wr, int wc, int fr, int fq) const {
        const int row0 = u.pm * BM + wr * 64 + fr, col0 = u.pn * BM + wc * 32 + 8 * fq;
#pragma unroll
        for (int ai = 0; ai < 2; ++ai)
#pragma unroll
            for (int m = 0; m < 4; ++m) { const size_t ro = (size_t)(row0 + ai * HALF + m * 16) * ldc + col0;
#pragma unroll
                for (int bj = 0; bj < 2; ++bj) {
                    if (RB) { const u32x4 w = *(const u32x4*)(Rb + ro + bj * HALF);
                        acc[ai][bj][m][0] = (f32x4){__uint_as_float(w.x << 16), __uint_as_float(w.x & 0xFFFF0000u), __uint_as_float(w.y << 16), __uint_as_float(w.y & 0xFFFF0000u)};
                        acc[ai][bj][m][1] = (f32x4){__uint_as_float(w.z << 16), __uint_as_float(w.z & 0xFFFF0000u), __uint_as_float(w.w << 16), __uint_as_float(w.w & 0xFFFF0000u)}; }
                    else { acc[ai][bj][m][0] = *(const f32x4*)(Rf + ro + bj * HALF); acc[ai][bj][m][1] = *(const f32x4*)(Rf + ro + bj * HALF + 4); } } }
    }
    DEV void operator()(const f32x4 (&acc)[2][2][4][2], const Unit& u, int wr, int wc, int fr, int fq) const {
        const int row0 = u.pm * BM + wr * 64 + fr, col0 = u.pn * BM + wc * 32 + 8 * fq;
#pragma unroll
        for (int ai = 0; ai < 2; ++ai)
#pragma unroll
            for (int m = 0; m < 4; ++m) { const size_t ro = (size_t)(row0 + ai * HALF + m * 16) * ldc + col0;
                float ss = 0.f;
#pragma unroll
                for (int bj = 0; bj < 2; ++bj) { const f32x4 v0 = acc[ai][bj][m][0], v1 = acc[ai][bj][m][1];
                    if (OB) { u32x4 w; w.x = cvt_pk_bf16(v0[0], v0[1]); w.y = cvt_pk_bf16(v0[2], v0[3]); w.z = cvt_pk_bf16(v1[0], v1[1]); w.w = cvt_pk_bf16(v1[2], v1[3]); *(u32x4*)(Cb + ro + bj * HALF) = w;
#pragma unroll
                        for (int e = 0; e < 4; ++e) { ss = fmaf(v0[e], v0[e], ss); ss = fmaf(v1[e], v1[e], ss); } }
                    else { *(f32x4*)(Cf + ro + bj * HALF) = v0; *(f32x4*)(Cf + ro + bj * HALF + 4) = v1; } }
                if (OB) {
                    ss += __shfl_xor(ss, 16); ss += __shfl_xor(ss, 32);
                    if (fq == 0) ssq[(size_t)(row0 + ai * HALF + m * 16) * 16 + u.pn * 4 + wc] = ss;
                } }
    }
};
template <class Epi, class Sched>
DEV void gemm_phase(PG8_LAS unsigned char* lds, const Gemm g, const Sched& S, const Epi& E) {
    const int tid = tidx(), wid = __builtin_amdgcn_readfirstlane(tid >> 6), lane = tid & 63, wr = wid >> 2, wc = wid & 3, fr = lane & 15, fq = lane >> 4;
    const int K = g.K, nt = K / BK;
    unsigned voffA[2], voffB[2];
#pragma unroll
    for (int i = 0; i < 2; ++i) { int R, C; stage_rc(tid * 16 + i * 8192, R, C); const int Rb = Epi::PERM ? ((R & ~31) + perm32(R & 31)) : R;
        voffA[i] = (unsigned)(R * K + C) * 2u; voffB[i] = (unsigned)(Rb * K + C) * 2u; }
    const size_t kstep = (size_t)(BK * 2);
    const size_t hstep = (size_t)HALF * K * 2;
    const size_t tstep = 2 * hstep;
    const unsigned ldsw = (unsigned)wid * 1024u;
    const int aoff = lds_byte(wr * 64 + fr, fq * 8), boff = lds_byte(wc * 32 + fr, fq * 8);
#define PG8_SA(b, h) (((b) * 2 + (h)) * HTB)
#define PG8_SB(b, h) ((4 + (b) * 2 + (h)) * HTB)
#define PG8_STAGE(bufoff, gbase, voff) do { _Pragma("unroll") for (int _i = 0; _i < 2; ++_i) \
        __builtin_amdgcn_global_load_lds((const unsigned*)((const char*)(gbase) + (voff)[_i]), (PG8_LAS unsigned*)(lds + (bufoff) + ldsw + _i * 8192), 16, 0, 0); } while (0)
#define PG8_LDA(dst, b, h) do { _Pragma("unroll") for (int m = 0; m < 4; ++m) _Pragma("unroll") for (int k = 0; k < 2; ++k) dst[m][k] = *(const PG8_LAS bf16x8*)(lds + PG8_SA(b, h) + aoff + m * 2048 + k * 1024); } while (0)
#define PG8_LDB(dst, b, h) do { _Pragma("unroll") for (int n = 0; n < 2; ++n) _Pragma("unroll") for (int k = 0; k < 2; ++k) dst[n][k] = *(const PG8_LAS bf16x8*)(lds + PG8_SB(b, h) + boff + n * 2048 + k * 1024); } while (0)
#define PG8_MMA(ai, bj, At, Bt) do { __builtin_amdgcn_s_setprio(1); _Pragma("unroll") for (int m = 0; m < 4; ++m) _Pragma("unroll") for (int n = 0; n < 2; ++n) _Pragma("unroll") for (int k = 0; k < 2; ++k) \
        acc[ai][bj][m][n] = __builtin_amdgcn_mfma_f32_16x16x32_bf16(Bt[n][k], At[m][k], acc[ai][bj][m][n], 0, 0, 0); __builtin_amdgcn_s_setprio(0); } while (0)
#define PG8_WAIT_V(n) asm volatile("s_waitcnt vmcnt(" #n ")" ::: "memory")
#define PG8_WAIT_L(n) asm volatile("s_waitcnt lgkmcnt(" #n ")" ::: "memory")
#define PG8_BAR __builtin_amdgcn_s_barrier()
#define PG8_SCHED __builtin_amdgcn_sched_barrier(0)
    Unit cur, nxt; int ui = 0;
    if (!S.next(0, cur)) return;
    f32x4 acc[2][2][4][2];
    if (Epi::INIT_LOAD) E.load(acc, cur, wr, wc, fr, fq);
    else {
#pragma unroll
        for (int a = 0; a < 2; ++a)
#pragma unroll
            for (int b = 0; b < 2; ++b)
#pragma unroll
                for (int m = 0; m < 4; ++m)
#pragma unroll
                    for (int n = 0; n < 2; ++n) acc[a][b][m][n] = (f32x4){0.f, 0.f, 0.f, 0.f};
    }
    bf16x8 At[4][2], B0[2][2], B1[2][2];
    const char* cA = (const char*)g.A + (size_t)cur.pm * tstep; const char* cB = (const char*)g.Bt + (size_t)cur.pn * tstep;
    PG8_STAGE(PG8_SB(0, 0), cB, voffB); PG8_STAGE(PG8_SA(0, 0), cA, voffA); PG8_STAGE(PG8_SB(0, 1), cB + hstep, voffB); PG8_STAGE(PG8_SA(0, 1), cA + hstep, voffA);
    if (wr == 1) PG8_BAR;
    PG8_WAIT_V(4); PG8_BAR;
    PG8_STAGE(PG8_SB(1, 0), cB + kstep, voffB); PG8_STAGE(PG8_SA(1, 0), cA + kstep, voffA); PG8_STAGE(PG8_SB(1, 1), cB + hstep + kstep, voffB);
    PG8_WAIT_V(6); PG8_BAR;
    for (;;) {
        const bool has_next = S.next(ui + 1, nxt);
        const char* nA = has_next ? (const char*)g.A + (size_t)nxt.pm * tstep : cA; const char* nB = has_next ? (const char*)g.Bt + (size_t)nxt.pn * tstep : cB;
        for (int t = 0; t < nt; t += 2) {
            const bool last = (t == nt - 2);
            const char* a1 = cA + (size_t)(t + 1) * kstep;
            const char* a2 = last ? nA : cA + (size_t)(t + 2) * kstep; const char* b2 = last ? nB : cB + (size_t)(t + 2) * kstep;
            const char* a3 = a2 + kstep; const char* b3 = b2 + kstep;
            PG8_LDB(B0, 0, 0); PG8_SCHED; PG8_LDA(At, 0, 0); PG8_STAGE(PG8_SA(1, 1), a1 + hstep, voffA);
            PG8_WAIT_L(8); PG8_BAR; PG8_WAIT_L(0); PG8_MMA(0, 0, At, B0); PG8_BAR; PG8_SCHED;
            PG8_LDB(B1, 0, 1); PG8_STAGE(PG8_SB(0, 0), b2, voffB);
            PG8_BAR; PG8_WAIT_L(0); PG8_MMA(0, 1, At, B1); PG8_BAR;
            PG8_LDA(At, 0, 1); PG8_STAGE(PG8_SA(0, 0), a2, voffA);
            PG8_BAR; PG8_WAIT_L(0); PG8_MMA(1, 0, At, B0); PG8_BAR; PG8_SCHED;
            PG8_STAGE(PG8_SB(0, 1), b2 + hstep, voffB);
            PG8_WAIT_V(6); PG8_BAR; PG8_MMA(1, 1, At, B1); PG8_BAR;
            PG8_LDB(B0, 1, 0); PG8_SCHED; PG8_LDA(At, 1, 0); PG8_STAGE(PG8_SA(0, 1), a2 + hstep, voffA);
            PG8_WAIT_L(8); PG8_BAR; PG8_WAIT_L(0); PG8_MMA(0, 0, At, B0); PG8_BAR; PG8_SCHED;
            PG8_LDB(B1, 1, 1); PG8_STAGE(PG8_SB(1, 0), b3, voffB);
            PG8_BAR; PG8_WAIT_L(0); PG8_MMA(0, 1, At, B1); PG8_BAR;
            PG8_LDA(At, 1, 1); PG8_STAGE(PG8_SA(1, 0), a3, voffA);
            PG8_BAR; PG8_WAIT_L(0); PG8_MMA(1, 0, At, B0); PG8_BAR; PG8_SCHED;
            PG8_STAGE(PG8_SB(1, 1), b3 + hstep, voffB);
            PG8_WAIT_V(6); PG8_BAR; PG8_MMA(1, 1, At, B1); PG8_BAR;
        }
        E(acc, cur, wr, wc, fr, fq);
        if (!has_next) break;
        if (Epi::INIT_LOAD) E.load(acc, nxt, wr, wc, fr, fq);
        else {
#pragma unroll
            for (int a = 0; a < 2; ++a)
#pragma unroll
                for (int b = 0; b < 2; ++b)
#pragma unroll
                    for (int m = 0; m < 4; ++m)
#pragma unroll
                        for (int n = 0; n < 2; ++n) acc[a][b][m][n] = (f32x4){0.f, 0.f, 0.f, 0.f};
        }
        cur = nxt; cA = nA; cB = nB; ++ui;
    }
    PG8_WAIT_V(0);
    if (wr == 0) PG8_BAR;
    PG8_BAR;
#undef PG8_SA
#undef PG8_SB
#undef PG8_STAGE
#undef PG8_LDA
#undef PG8_LDB
#undef PG8_MMA
#undef PG8_WAIT_V
#undef PG8_WAIT_L
#undef PG8_BAR
#undef PG8_SCHED
}
}
DEV void phase_gemm_in(CP p, int l, int bid, int nb, char* lds) {
    pg8::StaticOrder S; S.init(NTOK, DP, nb, bid);
    if (l == 0) { pg8::Gemm g{p.H, p.wt_in, NTOK, DP, DM}; pg8::EpiBf16 E{p.P, DP}; pg8::gemm_phase((PG8_LAS unsigned char*)lds, g, S, E); }
    else {
        PG8_LAS float* rtab = (PG8_LAS float*)((PG8_LAS char*)lds + 131072);
        const int tid = tidx(), row = tid >> 1, h = tid & 1;
        for (int i = 0;; ++i) {
            pg8::Unit u; if (!S.next(i, u)) break;
            const pg8::f32x4* q = (const pg8::f32x4*)(p.ssq + (size_t)(u.pm * pg8::BM + row) * 16 + 8 * h);
            const pg8::f32x4 a = q[0], b = q[1];
            float t = ((a[0] + a[1]) + (a[2] + a[3])) + ((b[0] + b[1]) + (b[2] + b[3]));
            t += __shfl_xor(t, 1);
            if (h == 0) rtab[i * pg8::BM + row] = rsqrtf(t * (1.f / DM) + EPS);
        }
        __syncthreads();
        pg8::Gemm g{p.x1b, p.wt_in + (size_t)DP * DM, NTOK, DP, DM}; pg8::EpiBf16S E{p.P, DP, rtab, 0}; pg8::gemm_phase((PG8_LAS unsigned char*)lds, g, S, E);
    }
}
DEV void phase_gemm_out(CP p, int l, int bid, int nb, char* lds, float* outp) {
    pg8::Gemm g{p.H, p.wt_out + (size_t)l * DM * DM, NTOK, DM, DM};
    pg8::StaticOrder S; S.init(NTOK, DM, nb, bid);
    if (l == 0) { pg8::EpiRes<false, true> E{p.x, nullptr, nullptr, p.x1b, DM, p.ssq}; pg8::gemm_phase((PG8_LAS unsigned char*)lds, g, S, E); }
    else { pg8::EpiRes<true, false> E{nullptr, p.x1b, outp, nullptr, DM, nullptr}; pg8::gemm_phase((PG8_LAS unsigned char*)lds, g, S, E); }
}

DEV void head_norm_inplace(bf16_t* v, const float* __restrict__ g, int lane) {
    const float x = bf2f(v[lane]); const float r = rsqrtf(wave_sum(x * x) * (1.f / 64.f) + EPS); v[lane] = f2bf(x * r * g[lane]);
}
DEV void phase2_post_naive(CP p, int l, int bid, int nb, char* lds) {
    const int wid = tidx() >> 6, lane = tidx() & 63;
    float* cn = (float*)lds + wid * 128;
    for (int tok = bid * NWAVES + wid; tok < NTOK; tok += nb * NWAVES) {
        bf16_t* row = p.P + (size_t)tok * DP;
        for (int h = 0; h < 8; ++h) head_norm_inplace(row + C_QA + h * 64, p.q_norm_a + l * 64, lane);
        for (int h = 0; h < 8; ++h) head_norm_inplace(row + C_QB + h * 64, p.q_norm_b + l * 64, lane);
        for (int g = 0; g < 2; ++g) head_norm_inplace(row + C_KS + g * 64, p.k_norm_slc + l * 64, lane);
        for (int g = 0; g < 2; ++g) head_norm_inplace(row + C_KW + g * 64, p.k_norm_win + l * 64, lane);
        if (lane < 24) row[C_GB + lane] = f2bf(sigmoidf_(bf2f(row[C_GB + lane]) + p.b_gate_b[l * 24 + lane]));
        const float c0 = bf2f(row[C_CKV + lane]), c1 = bf2f(row[C_CKV + 64 + lane]);
        const float r = rsqrtf(wave_sum(c0 * c0 + c1 * c1) * (1.f / 128.f) + EPS);
        cn[lane] = c0 * r * p.kv_norm_a[l * 128 + lane]; cn[64 + lane] = c1 * r * p.kv_norm_a[l * 128 + 64 + lane];
        __builtin_amdgcn_wave_barrier();
        float o[4];
#pragma unroll
        for (int i = 0; i < 4; ++i) {
            const bf16_t* w = p.wt_kvup + (size_t)l * 256 * 128 + (size_t)(lane + 64 * i) * 128; float acc = 0.f;
            for (int k = 0; k < 128; ++k) acc = fmaf(cn[k], bf2f(w[k]), acc);
            o[i] = acc;
        }
        __builtin_amdgcn_wave_barrier();
#pragma unroll
        for (int g = 0; g < 2; ++g) {
            const float rr = rsqrtf(wave_sum(o[g] * o[g]) * (1.f / 64.f) + EPS);
            p.Ka[(size_t)tok * 128 + g * 64 + lane] = f2bf(o[g] * rr * p.k_norm_a[l * 64 + lane]);
            p.Va[(size_t)tok * 128 + g * 64 + lane] = f2bf(o[2 + g]);
        }
    }
    const int NCI = NBATCH * 2 * 2 * 256;
    for (int it = bid * NWAVES + wid; it < NCI; it += nb * NWAVES) {
        const int c = it & 255, kv = (it >> 8) & 1, g = (it >> 9) & 1, b = it >> 10;
        bf16_t* dst = (kv ? p.Vc : p.Kc) + ((size_t)(b * 2 + g) * 256 + c) * 64;
        if (c == 255) { dst[lane] = 0; continue; }
        const bf16_t* w1 = (kv ? p.wt_c1v : p.wt_c1k) + (size_t)l * 64 * 2048 + (size_t)lane * 2048;
        const int col = (kv ? C_VC : C_KC) + g * 64;
        float acc = 0.f;
        for (int j = 0; j < 32; ++j) {
            const bf16_t* xin = p.P + (size_t)(b * SEQ + 16 * c + j) * DP + col;
            for (int d = 0; d < 64; ++d) acc = fmaf(bf2f(xin[d]), bf2f(w1[j * 64 + d]), acc);
        }
        const float h1 = gelu_tanh(acc + (kv ? p.cbias_v : p.cbias_k)[l * 64 + lane]);
        const bf16_t* w2 = (kv ? p.wt_c2v : p.wt_c2k) + (size_t)l * 64 * 64 + (size_t)lane * 64;
        float o2 = 0.f;
        for (int n = 0; n < 64; ++n) o2 = fmaf(__shfl(h1, n), bf2f(w2[n]), o2);
        if (!kv) { const float rr = rsqrtf(wave_sum(o2 * o2) * (1.f / 64.f) + EPS); o2 = o2 * rr * p.k_norm_cmp[l * 64 + lane]; }
        dst[lane] = f2bf(o2);
    }
}

DEV void wave_kth_largest(const unsigned* keys, int n, int K, int lane, unsigned& T, int& cgt) {
    unsigned prefix = 0u;
    for (int bit = 31; bit >= 0; --bit) {
        const unsigned cand = prefix | (1u << bit);
        int cnt = 0;
        for (int i = lane; i < n; i += 64) cnt += (keys[i] >= cand) ? 1 : 0;
        cnt = wave_sum_i(cnt);
        if (cnt >= K) prefix = cand;
    }
    int c2 = 0;
    for (int i = lane; i < n; i += 64) c2 += (keys[i] > prefix) ? 1 : 0;
    T = prefix; cgt = wave_sum_i(c2);
}
DEV void wave_compact(const unsigned* keys, int n, int K, unsigned T, int cgt, int lane, int* sel) {
    int base = 0, eqseen = 0; const int need = K - cgt;
    const u64 lt = (lane == 0) ? 0ull : (~0ull >> (64 - lane));
    for (int i0 = 0; i0 < n; i0 += 64) {
        const int i = i0 + lane; const bool v = i < n; const unsigned k = v ? keys[i] : 0u;
        const bool gt = v && k > T, eq = v && k == T;
        const u64 beq = __ballot(eq); const int eqrank = eqseen + __popcll(beq & lt);
        const bool take = gt || (eq && eqrank < need);
        const u64 bt = __ballot(take); const int pos = base + __popcll(bt & lt);
        if (take) sel[pos] = i;
        base += __popcll(bt); eqseen += __popcll(beq);
    }
}

DEV void phase3_dsa_naive(CP p, int l, int bid, int nb, char* lds) {
    const int tid = tidx(), wid = tid >> 6, lane = tid & 63;
    unsigned* keys = (unsigned*)lds;
    float* qidx = (float*)(lds + 16384);
    float* qa = qidx + 512;
    float* wv = qa + 512;
    int* sel = (int*)(wv + 16);
    float* pw = (float*)(sel + 256);
    for (int item = bid; item < NTOK; item += nb) {
        const int b = item / SEQ, t = item % SEQ;
        const bf16_t* row = p.P + (size_t)item * DP;
        qidx[tid] = bf2f(row[C_QI + tid]); qa[tid] = bf2f(row[C_QA + tid]);
        if (tid < 8) wv[tid] = bf2f(row[C_WI + tid]) * 0.35355339059327373f;
        __syncthreads();
        const int n = t + 1;
        for (int s = tid; s < n; s += NTHREADS) {
            const bf16_t* kr = p.P + (size_t)(b * SEQ + s) * DP + C_KI;
            float sc = 0.f;
#pragma unroll 1
            for (int h = 0; h < 8; ++h) { const float d = dot64(kr, qidx + h * 64) * 0.125f; sc = fmaf(wv[h], fmaxf(d, 0.f), sc); }
            keys[s] = f2key(sc);
        }
        __syncthreads();
        int nsel;
        if (n <= 256) { nsel = n; if (tid < n) sel[tid] = tid; }
        else { nsel = 256; if (wid == 0) { unsigned T; int cgt; wave_kth_largest(keys, n, 256, lane, T, cgt); wave_compact(keys, n, 256, T, cgt, lane, sel); } }
        __syncthreads();
        {
            const int h = wid, g = h >> 2;
            float m = -INFINITY;
#pragma unroll 1
            for (int i = 0; i < 4; ++i) {
                const int j = lane + 64 * i; float v = -INFINITY;
                if (j < nsel) { const int s = sel[j]; v = dot64(p.Ka + (size_t)(b * SEQ + s) * 128 + g * 64, qa + h * 64) * 0.125f + p.biasd[h * 1024 + min(t - s, 1023)]; }
                pw[h * 256 + j] = v; m = fmaxf(m, v);
            }
            m = wave_max(m);
            float sum = 0.f;
#pragma unroll 1
            for (int i = 0; i < 4; ++i) { const int j = lane + 64 * i; const float v = pw[h * 256 + j]; const float e = (j < nsel) ? __expf(v - m) : 0.f; pw[h * 256 + j] = e; sum += e; }
            sum = wave_sum(sum); const float inv = 1.f / sum;
            __builtin_amdgcn_wave_barrier();
            float o = 0.f;
            for (int j = 0; j < nsel; ++j) o = fmaf(pw[h * 256 + j], bf2f(p.Va[(size_t)(b * SEQ + sel[j]) * 128 + g * 64 + lane]), o);
            o *= inv;
            const float z = bf2f(row[C_ZA + h * 64 + lane]);
            p.H[(size_t)item * DM + h * 64 + lane] = f2bf(o * silu(z));
        }
        __syncthreads();
    }
}

DEV void phase3_nsa_naive(CP p, int l, int bid, int nb, char* lds) {
    const int tid = tidx(), wid = tid >> 6, lane = tid & 63;
    float* qb = (float*)lds;
    float* pc = qb + 512;
    float* lgs = pc + 2048;
    float* imp = lgs + 8192;
    int* selflag = (int*)(imp + 128);
    int* sblk = selflag + 128;
    int* nsb = sblk + 32;
    for (int item = bid; item < NTOK; item += nb) {
        const int b = item / SEQ, t = item % SEQ;
        const bf16_t* row = p.P + (size_t)item * DP;
        qb[tid] = bf2f(row[C_QB + tid]);
        __syncthreads();
        const int h = wid, g = h >> 2;
        const float* q = qb + h * 64;
        const float* bd = p.biasd + (8 + h) * 1024;
        float oc = 0.f;
        {
            float m = -INFINITY;
#pragma unroll 1
            for (int i = 0; i < 4; ++i) {
                const int c = lane + 64 * i; const int dist = t - (16 * c + 31); float v = -INFINITY;
                if (c < 255 && dist >= 0) v = dot64(p.Kc + ((size_t)(b * 2 + g) * 256 + c) * 64, q) * 0.125f + bd[min(dist, 1023)];
                pc[h * 256 + c] = v; m = fmaxf(m, v);
            }
            m = wave_max(m);
            float sum = 0.f;
#pragma unroll 1
            for (int i = 0; i < 4; ++i) { const int c = lane + 64 * i; const float v = pc[h * 256 + c]; const float e = (v > -INFINITY) ? __expf(v - m) : 0.f; pc[h * 256 + c] = e; sum += e; }
            sum = wave_sum(sum); const float inv = sum > 0.f ? 1.f / sum : 0.f;
#pragma unroll 1
            for (int i = 0; i < 4; ++i) pc[h * 256 + lane + 64 * i] *= inv;
            __builtin_amdgcn_wave_barrier();
            const int ncv = (t >= 31) ? min(255, (t - 31) / 16 + 1) : 0;
            for (int c = 0; c < ncv; ++c) oc = fmaf(pc[h * 256 + c], bf2f(p.Vc[((size_t)(b * 2 + g) * 256 + c) * 64 + lane]), oc);
        }
        __syncthreads();
        const int jt = t >> 6;
        if (tid < 128) {
            const int gg = tid >> 6, n = tid & 63; float s = 0.f;
#pragma unroll
            for (int r = 0; r < 4; ++r) { const float* pr = pc + (gg * 4 + r) * 256; s += pr[4 * n] + pr[4 * n + 1] + pr[4 * n + 2] + 0.5f * pr[4 * n + 3] + (n > 0 ? 0.5f * pr[4 * n - 1] : 0.f); }
            if (n == 0 || n == jt || n == jt - 1) s += 1e4f;
            if (n * 64 > t) s = -INFINITY;
            imp[tid] = s;
        }
        __syncthreads();
        if (tid < 128) {
            const int gg = tid >> 6, n = tid & 63; const float v = imp[tid]; int rank = 0;
            for (int m2 = 0; m2 < 64; ++m2) { const float u = imp[gg * 64 + m2]; rank += (u > v || (u == v && m2 < n)) ? 1 : 0; }
            selflag[tid] = (rank < 16 && n * 64 <= t) ? 1 : 0;
        }
        __syncthreads();
        if (tid < 128) {
            const int gg = tid >> 6, n = tid & 63;
            if (selflag[tid]) { int pos = 0; for (int m2 = 0; m2 < n; ++m2) pos += selflag[gg * 64 + m2]; sblk[gg * 16 + pos] = n; }
            if (n == 0) { int c = 0; for (int m2 = 0; m2 < 64; ++m2) c += selflag[gg * 64 + m2]; nsb[gg] = c; }
        }
        __syncthreads();
        float os = 0.f;
        {
            const int ns = nsb[g]; float m = -INFINITY;
            for (int j = 0; j < ns; ++j) {
                const int s = sblk[g * 16 + j] * 64 + lane; float v = -INFINITY;
                if (s <= t) v = dot64(p.P + (size_t)(b * SEQ + s) * DP + C_KS + g * 64, q) * 0.125f + bd[min(t - s, 1023)];
                lgs[h * 1024 + j * 64 + lane] = v; m = fmaxf(m, v);
            }
            m = wave_max(m); float sum = 0.f;
            for (int j = 0; j < ns; ++j) { const float v = lgs[h * 1024 + j * 64 + lane]; const float e = (v > -INFINITY) ? __expf(v - m) : 0.f; lgs[h * 1024 + j * 64 + lane] = e; sum += e; }
            sum = wave_sum(sum); const float inv = sum > 0.f ? 1.f / sum : 0.f;
            __builtin_amdgcn_wave_barrier();
            for (int j = 0; j < ns; ++j) {
                const int s0 = sblk[g * 16 + j] * 64;
                for (int k = 0; k < 64; ++k) { if (s0 + k > t) break; os = fmaf(lgs[h * 1024 + j * 64 + k], bf2f(p.P[(size_t)(b * SEQ + s0 + k) * DP + C_VS + g * 64 + lane]), os); }
            }
            os *= inv;
            __builtin_amdgcn_wave_barrier();
        }
        float ow = 0.f;
        {
            const int s0 = max(0, t - 511); float m = -INFINITY;
#pragma unroll 1
            for (int i = 0; i < 8; ++i) {
                const int s = s0 + lane + 64 * i; float v = -INFINITY;
                if (s <= t) v = dot64(p.P + (size_t)(b * SEQ + s) * DP + C_KW + g * 64, q) * 0.125f + bd[t - s];
                lgs[h * 1024 + lane + 64 * i] = v; m = fmaxf(m, v);
            }
            m = wave_max(m); float sum = 0.f;
#pragma unroll 1
            for (int i = 0; i < 8; ++i) { const float v = lgs[h * 1024 + lane + 64 * i]; const float e = (v > -INFINITY) ? __expf(v - m) : 0.f; lgs[h * 1024 + lane + 64 * i] = e; sum += e; }
            sum = wave_sum(sum); const float inv = 1.f / sum;
            __builtin_amdgcn_wave_barrier();
            const int cnt = t - s0 + 1;
            for (int k = 0; k < cnt; ++k) ow = fmaf(lgs[h * 1024 + k], bf2f(p.P[(size_t)(b * SEQ + s0 + k) * DP + C_VW + g * 64 + lane]), ow);
            ow *= inv;
        }
        const float gc = bf2f(row[C_GB + h * 3 + 0]), gs = bf2f(row[C_GB + h * 3 + 1]), gw = bf2f(row[C_GB + h * 3 + 2]);
        const float o = gc * oc + gs * os + gw * ow;
        const float z = bf2f(row[C_ZB + h * 64 + lane]);
        p.H[(size_t)item * DM + 512 + h * 64 + lane] = f2bf(o * silu(z));
        __syncthreads();
    }
}


namespace nsa {
typedef unsigned u32x2 __attribute__((ext_vector_type(2)));
#define LAS __attribute__((address_space(3)))
typedef short bf16x8 __attribute__((ext_vector_type(8)));
typedef short s16x4 __attribute__((ext_vector_type(4)));
typedef float f32x16 __attribute__((ext_vector_type(16)));
typedef unsigned u32x4 __attribute__((ext_vector_type(4)));
constexpr float LOG2E = 1.4426950408889634f, C2 = 0.125f * LOG2E, M0 = 8.0f;
constexpr int RT_STRIDE = 1160, RT_NEG = 1088;
constexpr int L_K = 0, L_V = 16384, L_BIAS = 32768, L_IMP = L_BIAS + 4 * RT_STRIDE * 4, IMP_Q = 68, L_WGM = L_IMP + 8 * 8 * 2 * IMP_Q * 4, L_OF = L_WGM + 128, L_END = L_OF + 8 * 8192;
DEV f32x16 MF(bf16x8 a, bf16x8 b, f32x16 c) { return __builtin_amdgcn_mfma_f32_32x32x16_bf16(a, b, c, 0, 0, 0); }
DEV float swap_max(float v) { auto rr = __builtin_amdgcn_permlane32_swap(__float_as_uint(v), __float_as_uint(v), false, false); return fmaxf(__uint_as_float(rr[0]), __uint_as_float(rr[1])); }
DEV float swap_sum(float v) { auto rr = __builtin_amdgcn_permlane32_swap(__float_as_uint(v), __float_as_uint(v), false, false); return __uint_as_float(rr[0]) + __uint_as_float(rr[1]); }
DEV float ex2(float x) { return __builtin_amdgcn_exp2f(x); }
template <int SUB>
DEV void vtr8(const LAS char* vb, s16x4 (&va)[2][2][2]) {
    long r0, r1, r2, r3, r4, r5, r6, r7;
    constexpr int B = 32 * SUB * 64;
    asm volatile("ds_read_b64_tr_b16 %0, %8 offset:%9\n\tds_read_b64_tr_b16 %1, %8 offset:%10\n\tds_read_b64_tr_b16 %2, %8 offset:%11\n\tds_read_b64_tr_b16 %3, %8 offset:%12\n\t"
                 "ds_read_b64_tr_b16 %4, %8 offset:%13\n\tds_read_b64_tr_b16 %5, %8 offset:%14\n\tds_read_b64_tr_b16 %6, %8 offset:%15\n\tds_read_b64_tr_b16 %7, %8 offset:%16\n\ts_waitcnt lgkmcnt(0)"
                 : "=&v"(r0), "=&v"(r1), "=&v"(r2), "=&v"(r3), "=&v"(r4), "=&v"(r5), "=&v"(r6), "=&v"(r7)
                 : "v"(vb), "n"(B), "n"(B + 512), "n"(B + 4096), "n"(B + 4096 + 512), "n"(B + 1024), "n"(B + 1024 + 512), "n"(B + 4096 + 1024), "n"(B + 4096 + 1024 + 512)
                 : "memory");
    va[0][0][0] = __builtin_bit_cast(s16x4, r0); va[0][0][1] = __builtin_bit_cast(s16x4, r1); va[0][1][0] = __builtin_bit_cast(s16x4, r2); va[0][1][1] = __builtin_bit_cast(s16x4, r3);
    va[1][0][0] = __builtin_bit_cast(s16x4, r4); va[1][0][1] = __builtin_bit_cast(s16x4, r5); va[1][1][0] = __builtin_bit_cast(s16x4, r6); va[1][1][1] = __builtin_bit_cast(s16x4, r7);
}
DEV float quad_sum(float v) {
    v += __int_as_float(__builtin_amdgcn_update_dpp(0, __float_as_int(v), 0xB1, 0xF, 0xF, true));
    v += __int_as_float(__builtin_amdgcn_update_dpp(0, __float_as_int(v), 0x4E, 0xF, 0xF, true));
    return v;
}
typedef short v4i16_t __attribute__((ext_vector_type(4)));
DEV s16x4 vtr(const LAS char* p) { return __builtin_bit_cast(s16x4, __builtin_amdgcn_ds_read_tr16_b64_v4i16((LAS v4i16_t*)p)); }
DEV unsigned cvtpk(float lo, float hi) { return cvt_pk_rne(lo, hi); }

DEV void pv_half(const f32x16& s, int sub, const LAS char* vbuf, f32x16& o0, f32x16& o1, int hi, int lane) {
    const int q4 = (lane & 15) >> 2, p4 = lane & 3, dh = (lane >> 4) & 1;
    const LAS char* vb = vbuf + (4 * hi + q4) * 64 + 32 * dh + 8 * p4;
    s16x4 va[2][2][2];
    if (sub == 0) vtr8<0>(vb, va); else vtr8<1>(vb, va);
#pragma unroll
    for (int s2 = 0; s2 < 2; ++s2) {
        union { unsigned u[4]; bf16x8 v; } pb;
#pragma unroll
        for (int j = 0; j < 4; ++j) pb.u[j] = cvtpk(s[8 * s2 + 2 * j], s[8 * s2 + 2 * j + 1]);
#pragma unroll
        for (int mt = 0; mt < 2; ++mt) {
            const bf16x8 vf = __builtin_shufflevector(va[s2][mt][0], va[s2][mt][1], 0, 1, 2, 3, 4, 5, 6, 7);
            if (mt == 0) o0 = MF(vf, pb.v, o0); else o1 = MF(vf, pb.v, o1);
        }
    }
}
DEV void qk_half(f32x16& s, int sub, const LAS char* kbuf, const bf16x8 (&qf)[4], int r32, int hi) {
    bf16x8 kf[4];
#pragma unroll
    for (int ks = 0; ks < 4; ++ks) kf[ks] = *(const LAS bf16x8*)(kbuf + (2 * ks + hi) * 1024 + (32 * sub + r32) * 16);
    asm volatile("" : "+v"(kf[0]), "+v"(kf[1]), "+v"(kf[2]), "+v"(kf[3]));
#pragma unroll
    for (int ks = 0; ks < 4; ++ks) s = MF(kf[ks], qf[ks], s);
}
template <int PASS>
DEV void cmp_tile(const LAS char* kbuf, const LAS char* vbuf, int key0, int t, const LAS float* rt, const bf16x8 (&qf)[4],
                  float& l, f32x16& o0, f32x16& o1, float invl, LAS float* impq, int r32, int hi, int lane) {
    float sum = 0.f;
#pragma unroll
    for (int sub = 0; sub < 2; ++sub) {
        f32x16 s;
        const int ix0 = 1023 - (t - 16 * (key0 + 32 * sub + 4 * hi) - 31);
#pragma unroll
        for (int r = 0; r < 16; ++r) { s[r] = rt[min(max(ix0 + 16 * ((r & 3) + 8 * (r >> 2)), 0), 1024)];
            if (PASS == 1) { s[r] += invl; if (r & 1) asm("" : "+v"(s[r])); } }
        qk_half(s, sub, kbuf, qf, r32, hi);
#pragma unroll
        for (int r = 0; r < 16; ++r) {
            float e = ex2(s[r]);
            s[r] = e; sum += e;
        }
        if (PASS == 1) {
            pv_half(s, sub, vbuf, o0, o1, hi, lane);
#pragma unroll
            for (int i = 0; i < 4; ++i) {
                const int n = (key0 >> 2) + 8 * sub + 2 * i + hi;
                float p3 = 0.5f * s[4 * i + 3];
                float mainv = (s[4 * i] + s[4 * i + 1]) + (s[4 * i + 2] + p3);
                mainv = quad_sum(mainv); p3 = quad_sum(p3);
                if ((lane & 3) == 0) { impq[n] = mainv; impq[IMP_Q + n + 1] = p3; }
            }
        }
        __builtin_amdgcn_sched_barrier(0);
    }
    if (PASS == 0) l += sum;
}
template <bool FAR, int MK>
DEV void hot_tile(const LAS char* kbuf, const LAS char* vbuf, int tl, float cb, const LAS float* rtb, const bf16x8 (&qf)[4],
                  float& l, f32x16& o0, f32x16& o1, int r32, int hi, int lane) {
    const int q4 = (lane & 15) >> 2, p4 = lane & 3, dh = (lane >> 4) & 1;
    const LAS char* vb = vbuf + (4 * hi + q4) * 64 + 32 * dh + 8 * p4;
    f32x16 s0, s1;
    bf16x8 kf[4];
#pragma unroll
    for (int r = 0; r < 16; ++r) s0[r] = FAR ? cb : rtb[8 * (r >> 2) + (r & 3)];
#pragma unroll
    for (int ks = 0; ks < 4; ++ks) kf[ks] = *(const LAS bf16x8*)(kbuf + (2 * ks + hi) * 1024 + r32 * 16);
#pragma unroll
    for (int ks = 0; ks < 4; ++ks) s0 = MF(kf[ks], qf[ks], s0);
#pragma unroll
    for (int r = 0; r < 16; ++r) s1[r] = FAR ? cb : rtb[32 + 8 * (r >> 2) + (r & 3)];
#pragma unroll
    for (int ks = 0; ks < 4; ++ks) kf[ks] = *(const LAS bf16x8*)(kbuf + (2 * ks + hi) * 1024 + (32 + r32) * 16);
    __builtin_amdgcn_sched_barrier(0);
    float sum = 0.f;
    unsigned pk[8];
#define NSA_EXPS(s, sub) do { _Pragma("unroll") for (int r = 0; r < 16; r += 2) { float v0 = s[r], v1 = s[r + 1]; \
        if (MK == 1) { const int kl = 32 * (sub) + (r & 3) + 8 * (r >> 2) + 4 * hi; v0 = (kl <= tl) ? v0 : -INFINITY; v1 = (kl + 1 <= tl) ? v1 : -INFINITY; } \
        if (MK == 2) { const int kl = 32 * (sub) + (r & 3) + 8 * (r >> 2) + 4 * hi; v0 = (kl > tl - 512) ? v0 : -INFINITY; v1 = (kl + 1 > tl - 512) ? v1 : -INFINITY; } \
        const float e0 = ex2(v0), e1 = ex2(v1); sum += e0; sum += e1; pk[r >> 1] = cvtpk(e0, e1); } } while (0)
#define NSA_PV(sub) do { _Pragma("unroll") for (int s2 = 0; s2 < 2; ++s2) { union { unsigned u[4]; bf16x8 v; } pb; \
        _Pragma("unroll") for (int j = 0; j < 4; ++j) pb.u[j] = pk[4 * s2 + j]; \
        _Pragma("unroll") for (int mt = 0; mt < 2; ++mt) { const bf16x8 vf = __builtin_shufflevector(va[s2][mt][0], va[s2][mt][1], 0, 1, 2, 3, 4, 5, 6, 7); \
            if (mt == 0) o0 = MF(vf, pb.v, o0); else o1 = MF(vf, pb.v, o1); } } } while (0)
#define NSA_VRD(sub) vtr8<sub>(vb, va)
    NSA_EXPS(s0, 0);
#pragma unroll
    for (int ks = 0; ks < 4; ++ks) s1 = MF(kf[ks], qf[ks], s1);
    s16x4 va[2][2][2];
    NSA_VRD(0);
    __builtin_amdgcn_sched_barrier(0);
    NSA_PV(0);
    NSA_VRD(1);
    NSA_EXPS(s1, 1);
    __builtin_amdgcn_sched_barrier(0);
    NSA_PV(1);
#undef NSA_EXPS
#undef NSA_PV
#undef NSA_VRD
    l += sum;
}
}

#ifdef SELFCHECK
#define NSA_CK(slot, expr) do { unsigned c_ = 0u; expr; _Pragma("unroll") for (int o_ = 1; o_ < 64; o_ <<= 1) c_ += __shfl_xor(c_, o_); if (lane == 0) atomicAdd(p.chk + 32 + pass * 8 + (slot), (unsigned long long)c_); } while (0)
#else
#define NSA_CK(slot, expr) do {} while (0)
#endif
DEV void phase3_nsa_fast(CP p, int l, int bid, int nb, char* lds_, int pass = 0) {
    using namespace nsa;
    LAS char* lds = (LAS char*)lds_;
    const int tid = tidx(), lane = tid & 63, r32 = lane & 31, hi = lane >> 5;
    const int wid = __builtin_amdgcn_readfirstlane(tid >> 6);
    constexpr int R_SLOT = 16384, L_RT = 3 * R_SLOT, L_WV = L_RT + 4 * RT_STRIDE * 4, L_WG = L_WV + 8 * 8192;
    LAS float* rt_l = (LAS float*)(lds + L_RT);
    LAS float* impw = (LAS float*)(lds + L_WV + wid * 8192);
    LAS float* ofs = impw + lane;
    LAS unsigned* wgm = (LAS unsigned*)(lds + L_WG);
    int sl = 0, g_tab = -1;
    const unsigned stoff = (unsigned)(tid * 16);
#define NSA_DMA(gbase, goff, slot, isv) do { const char* sb_ = (gbase) + (goff); asm volatile("" : "+s"(sb_));     \
        __builtin_amdgcn_global_load_lds((const unsigned*)(sb_ + stoff), (LAS unsigned*)(lds + (slot) * R_SLOT + (isv) * 8192 + wid * 1024), 16, 0, 0); } while (0)
#define NSA_WAIT(n) asm volatile("s_waitcnt vmcnt(" #n ")" ::: "memory")
#define NSA_BAR() do { asm volatile("" ::: "memory"); __builtin_amdgcn_s_barrier(); asm volatile("" ::: "memory"); } while (0)
#define NSA_NEXT(x) ((x) == 2 ? 0 : (x) + 1)
    for (int it = bid; it < NBATCH * 2 * 64; it += nb) {
        const int j = it / 256, rem = it % 256, b = rem & 7, g = (rem >> 3) & 1, a = rem >> 4;
        const int qt = (j & 1) ? (63 - 16 * j) - (15 - a) : (63 - 16 * j) - a;
        const int q0 = qt * 64;
        const int ql = r32 >> 2, rh = r32 & 3, head = g * 4 + rh;
        const int t = q0 + wid * 8 + ql;
        const size_t tokrow = (size_t)(b * SEQ + t);
        const bf16_t* prow = p.P + tokrow * DP;
        if (g != g_tab) {
            for (int e = tid; e < 4 * 1152; e += NTHREADS) {
                const int h = e / 1152, jj = e % 1152;
                float v = -INFINITY;
                if (jj < 1024) v = p.biasd[(8 + g * 4 + h) * 1024 + (1023 - jj)] * LOG2E - M0;
                rt_l[h * RT_STRIDE + jj] = v;
            }
            g_tab = g;
        }
        for (int e = lane; e < 8 * 2 * IMP_Q; e += 64) impw[e] = 0.f;
        if (tid < 2) wgm[tid] = 0u;
        const LAS float* rt = rt_l + rh * RT_STRIDE;
        bf16x8 qf[4];
#pragma unroll
        for (int ks = 0; ks < 4; ++ks) qf[ks] = *(const bf16x8*)(prow + C_QB + head * 64 + 16 * ks + 8 * hi);
        const char* Kc = (const char*)(p.Kc + (size_t)(b * 2 + g) * 256 * 64); const char* Vc = (const char*)(p.Vc + (size_t)(b * 2 + g) * 256 * 64);
        const int ntc = (4 * qt + 3 + 63) / 64;
        NSA_DMA(Kc, 0u, sl, 0); if (ntc > 1) NSA_DMA(Kc, 8192u, NSA_NEXT(sl), 0);
        {
            float xq[4][8]; float ss = 0.f;
#pragma unroll
            for (int ks = 0; ks < 4; ++ks) { unpack8g(__builtin_bit_cast(uint4, qf[ks]), xq[ks]);
#pragma unroll
                for (int jx = 0; jx < 8; ++jx) ss = fmaf(xq[ks][jx], xq[ks][jx], ss); }
            ss = swap_sum(ss);
            const float rq = rsqrtf(ss * (1.f / 64.f) + EPS) * C2;
#pragma unroll
            for (int ks = 0; ks < 4; ++ks) {
                const float* gq = p.q_norm_b + l * 64 + 16 * ks + 8 * hi;
                const float4 g0 = *(const float4*)gq, g1 = *(const float4*)(gq + 4);
                union { unsigned u[4]; bf16x8 v; } pk;
                pk.u[0] = cvtpk(xq[ks][0] * rq * g0.x, xq[ks][1] * rq * g0.y); pk.u[1] = cvtpk(xq[ks][2] * rq * g0.z, xq[ks][3] * rq * g0.w);
                pk.u[2] = cvtpk(xq[ks][4] * rq * g1.x, xq[ks][5] * rq * g1.y); pk.u[3] = cvtpk(xq[ks][6] * rq * g1.z, xq[ks][7] * rq * g1.w);
                qf[ks] = pk.v;
            }
        }
        const float gc = bf2f(prow[C_GB + head * 3 + 0]), gs = bf2f(prow[C_GB + head * 3 + 1]), gw = bf2f(prow[C_GB + head * 3 + 2]);
        f32x16 o0, o1;
#pragma unroll
        for (int r = 0; r < 16; ++r) { o0[r] = 0.f; o1[r] = 0.f; }
        __syncthreads();
        float lc = 0.f;
        {
            int s0 = sl, s1 = NSA_NEXT(sl);
            for (int i = 0; i < ntc; ++i) {
                if (i + 1 < ntc) NSA_WAIT(1); else NSA_WAIT(0);
                NSA_BAR();
                const int s2 = NSA_NEXT(s1);
                if (i + 2 < ntc) NSA_DMA(Kc, (unsigned)((i + 2) * 8192), s2, 0);
                cmp_tile<0>(lds + s0 * R_SLOT, nullptr, 64 * i, t, rt, qf, lc, o0, o1, 0.f, nullptr, r32, hi, lane);
                s0 = s1; s1 = s2;
            }
            sl = s0;
        }
        {
            const float lt = swap_sum(lc); const float invl = lt > 0.f ? -__builtin_amdgcn_logf(lt) : -INFINITY;
            LAS float* impq = impw + ql * 2 * IMP_Q;
            float ldummy = 0.f;
            int s0 = sl, s1 = NSA_NEXT(sl);
            NSA_DMA(Kc, 0u, s0, 0); NSA_DMA(Vc, 0u, s0, 1); if (ntc > 1) { NSA_DMA(Kc, 8192u, s1, 0); NSA_DMA(Vc, 8192u, s1, 1); }
            for (int i = 0; i < ntc; ++i) {
                if (i + 1 < ntc) NSA_WAIT(2); else NSA_WAIT(0);
                NSA_BAR();
                const int s2 = NSA_NEXT(s1);
                if (i + 2 < ntc) { NSA_DMA(Kc, (unsigned)((i + 2) * 8192), s2, 0); NSA_DMA(Vc, (unsigned)((i + 2) * 8192), s2, 1); }
                cmp_tile<1>(lds + s0 * R_SLOT, lds + s0 * R_SLOT + 8192, 64 * i, t, rt, qf, ldummy, o0, o1, invl, impq, r32, hi, lane);
                s0 = s1; s1 = s2;
            }
            sl = s0;
        }
        u64 mask;
        if (qt < 16) { mask = (2ull << qt) - 1ull; if (lane == 0) { __hip_atomic_fetch_or(wgm, (unsigned)mask, __ATOMIC_RELAXED, __HIP_MEMORY_SCOPE_WORKGROUP); } }
        else {
            const int rq = lane >> 3, part = lane & 7;
            LAS float* iq = impw + rq * 2 * IMP_Q;
            int v[8];
#pragma unroll
            for (int e = 0; e < 8; ++e) { const int n = e * 8 + part; float x = iq[n] + iq[IMP_Q + n]; if (n == 0 || n == qt || n == qt - 1) x += 1e4f; if (n > qt) x = -INFINITY; v[e] = (__float_as_int(x) & ~63) | (63 - n); }
            __builtin_amdgcn_wave_barrier();
            LAS int* iqi = (LAS int*)iq;
#pragma unroll
            for (int e = 0; e < 8; ++e) iqi[e * 8 + part] = v[e];
            __builtin_amdgcn_wave_barrier();
            int cnt[8];
#pragma unroll
            for (int e = 0; e < 8; ++e) cnt[e] = 0;
#pragma unroll 4
            for (int jj = 0; jj <= qt; ++jj) {
                const int u = iqi[jj];
#pragma unroll
                for (int e = 0; e < 8; ++e) cnt[e] += (u > v[e]) ? 1 : 0;
            }
            u64 m64 = 0ull, un = 0ull;
#pragma unroll
            for (int e = 0; e < 8; ++e) {
                const u64 bal = __ballot(cnt[e] < 16 && (e * 8 + part) <= qt);
                m64 |= ((bal >> (8 * ql)) & 0xFFull) << (8 * e);
                u64 f = bal | (bal >> 32); f |= f >> 16; f |= f >> 8;
                un |= (f & 0xFFull) << (8 * e);
            }
            mask = m64;
            if (lane == 0) { __hip_atomic_fetch_or(wgm, (unsigned)un, __ATOMIC_RELAXED, __HIP_MEMORY_SCOPE_WORKGROUP); __hip_atomic_fetch_or(wgm + 1, (unsigned)(un >> 32), __ATOMIC_RELAXED, __HIP_MEMORY_SCOPE_WORKGROUP); }
        }
        NSA_CK(0, c_ += (unsigned)mask + (unsigned)(mask >> 32));
        __builtin_amdgcn_wave_barrier();
#pragma unroll
        for (int r = 0; r < 16; ++r) { ofs[r * 64] = gc * o0[r]; ofs[(16 + r) * 64] = gc * o1[r]; o0[r] = 0.f; o1[r] = 0.f; }
        __syncthreads();
        const int tmin = q0 + wid * 8;
        const float cb31 = rt[0];
        const char* Kwb = (const char*)(p.Kw + (size_t)(b * 2 + g) * SEQ * 64); const char* Vwb = (const char*)(p.Vw + (size_t)(b * 2 + g) * SEQ * 64);
        const int nlo = max(0, qt - 8);
        int wpre = 0;
        {
            u64 todo = (u64)wgm[0] | ((u64)wgm[1] << 32);
            float ls = 0.f;
            const char* Kb = (const char*)(p.Ks + (size_t)(b * 2 + g) * SEQ * 64); const char* Vb = (const char*)(p.Vs + (size_t)(b * 2 + g) * SEQ * 64);
            int n0 = (int)__builtin_ctzll(todo); todo &= todo - 1;
            int n1 = todo ? (int)__builtin_ctzll(todo) : -1; todo &= todo - 1;
            int s0 = sl, s1 = NSA_NEXT(sl);
            NSA_DMA(Kb, (unsigned)(n0 * 8192), s0, 0); NSA_DMA(Vb, (unsigned)(n0 * 8192), s0, 1);
            if (n1 >= 0) { NSA_DMA(Kb, (unsigned)(n1 * 8192), s1, 0); NSA_DMA(Vb, (unsigned)(n1 * 8192), s1, 1); }
            for (;;) {
                const int n2 = (n1 >= 0 && todo) ? (int)__builtin_ctzll(todo) : -1; if (n2 >= 0) todo &= todo - 1;
                if (n1 >= 0 || wpre) NSA_WAIT(2); else NSA_WAIT(0);
                NSA_BAR();
                const int s2 = NSA_NEXT(s1);
                if (n2 >= 0) { NSA_DMA(Kb, (unsigned)(n2 * 8192), s2, 0); NSA_DMA(Vb, (unsigned)(n2 * 8192), s2, 1); }
                else if (n1 >= 0) {
                    if (wpre == 0) { NSA_DMA(Kwb, (unsigned)(nlo * 8192), s2, 0); NSA_DMA(Vwb, (unsigned)(nlo * 8192), s2, 1); wpre = 1; }
                } else {
                    if (wpre == 0) { NSA_DMA(Kwb, (unsigned)(nlo * 8192), s1, 0); NSA_DMA(Vwb, (unsigned)(nlo * 8192), s1, 1); wpre = 1;
                                     if (nlo + 1 <= qt) { NSA_DMA(Kwb, (unsigned)((nlo + 1) * 8192), s2, 0); NSA_DMA(Vwb, (unsigned)((nlo + 1) * 8192), s2, 1); wpre = 2; } }
                    else if (nlo + 1 <= qt) { NSA_DMA(Kwb, (unsigned)((nlo + 1) * 8192), s2, 0); NSA_DMA(Vwb, (unsigned)((nlo + 1) * 8192), s2, 1); wpre = 2; }
                }
                const int n = n0;
                const LAS char* kb_ = lds + s0 * R_SLOT; const LAS char* vb_ = kb_ + 8192;
                const bool lsel = (mask >> n) & 1ull;
                if (__any(lsel)) {
                    const int key0 = 64 * n, tl = t - key0;
                    if (tmin - key0 - 63 >= 790) hot_tile<true, 0>(kb_, vb_, tl, lsel ? cb31 : -INFINITY, rt, qf, ls, o0, o1, r32, hi, lane);
                    else {
                        const LAS float* rtb = lsel ? (rt + 1023 - tl + 4 * hi) : (rt + RT_NEG);
                        if (n == qt) hot_tile<false, 1>(kb_, vb_, tl, 0.f, rtb, qf, ls, o0, o1, r32, hi, lane);
                        else hot_tile<false, 0>(kb_, vb_, tl, 0.f, rtb, qf, ls, o0, o1, r32, hi, lane);
                    }
                }
                s0 = s1; s1 = s2;
                if (n1 < 0) break;
                n0 = n1; n1 = n2;
            }
            sl = s0;
            const float lt = swap_sum(ls); const float sc = lt > 0.f ? gs / lt : 0.f;
#pragma unroll
            for (int r = 0; r < 16; ++r) { ofs[r * 64] += sc * o0[r]; ofs[(16 + r) * 64] += sc * o1[r]; o0[r] = 0.f; o1[r] = 0.f; }
        }
        u32x2 zraw[2][4];
        {
            const bf16_t* zrow_ = prow + C_ZB + head * 64;
#pragma unroll
            for (int mt = 0; mt < 2; ++mt)
#pragma unroll
                for (int r4 = 0; r4 < 4; ++r4) zraw[mt][r4] = *(const u32x2*)(zrow_ + 32 * mt + 8 * r4 + 4 * hi);
            asm volatile("" ::: "memory");
        }
        {
            float lw = 0.f;
            const char* Kb = Kwb; const char* Vb = Vwb;
            int s0 = sl, s1 = NSA_NEXT(sl);
            if (wpre < 1) { NSA_DMA(Kb, (unsigned)(nlo * 8192), s0, 0); NSA_DMA(Vb, (unsigned)(nlo * 8192), s0, 1); }
            if (wpre < 2 && nlo + 1 <= qt) { NSA_DMA(Kb, (unsigned)((nlo + 1) * 8192), s1, 0); NSA_DMA(Vb, (unsigned)((nlo + 1) * 8192), s1, 1); }
            for (int n = nlo; n <= qt; ++n) {
                if (n + 1 <= qt) NSA_WAIT(2); else NSA_WAIT(0);
                NSA_BAR();
                const int s2 = NSA_NEXT(s1);
                if (n + 2 <= qt) { NSA_DMA(Kb, (unsigned)((n + 2) * 8192), s2, 0); NSA_DMA(Vb, (unsigned)((n + 2) * 8192), s2, 1); }
                const LAS char* kb_ = lds + s0 * R_SLOT; const LAS char* vb_ = kb_ + 8192;
                const int key0 = 64 * n, tl = t - key0;
                const LAS float* rtb = rt + 1023 - tl + 4 * hi;
                if (n == qt) hot_tile<false, 1>(kb_, vb_, tl, 0.f, rtb, qf, lw, o0, o1, r32, hi, lane);
                else if (n == qt - 8) hot_tile<false, 2>(kb_, vb_, tl, 0.f, rtb, qf, lw, o0, o1, r32, hi, lane);
                else hot_tile<false, 0>(kb_, vb_, tl, 0.f, rtb, qf, lw, o0, o1, r32, hi, lane);
                s0 = s1; s1 = s2;
            }
            sl = s0;
            const float lt = swap_sum(lw); const float sc = lt > 0.f ? gw / lt : 0.f;
#pragma unroll
            for (int r = 0; r < 16; ++r) { o0[r] = ofs[r * 64] + sc * o0[r]; o1[r] = ofs[(16 + r) * 64] + sc * o1[r]; }
        }
        {
            bf16_t* yrow = p.H + tokrow * DM + 512 + head * 64;
#pragma unroll
            for (int mt = 0; mt < 2; ++mt)
#pragma unroll
                for (int r4 = 0; r4 < 4; ++r4) {
                    const int d = 32 * mt + 8 * r4 + 4 * hi;
                    uint2 zz; zz.x = zraw[mt][r4][0]; zz.y = zraw[mt][r4][1];
                    const float z0 = __uint_as_float(zz.x << 16), z1 = __uint_as_float(zz.x & 0xFFFF0000u), z2 = __uint_as_float(zz.y << 16), z3 = __uint_as_float(zz.y & 0xFFFF0000u);
                    const f32x16& o = mt ? o1 : o0;
                    uint2 y; y.x = pk2(o[4 * r4] * silu(z0), o[4 * r4 + 1] * silu(z1)); y.y = pk2(o[4 * r4 + 2] * silu(z2), o[4 * r4 + 3] * silu(z3));
                    *(uint2*)(yrow + d) = y;
                }
        }
        asm volatile("s_waitcnt lgkmcnt(0)" ::: "memory"); __builtin_amdgcn_s_barrier(); asm volatile("" ::: "memory");
    }
#undef NSA_DMA
#undef NSA_WAIT
#undef NSA_BAR
#undef NSA_NEXT
}

namespace dsa {
typedef short bf16x8 __attribute__((ext_vector_type(8)));
typedef short s16x4 __attribute__((ext_vector_type(4)));
typedef float f32x4 __attribute__((ext_vector_type(4)));
typedef float f32x16 __attribute__((ext_vector_type(16)));
typedef unsigned u32x4 __attribute__((ext_vector_type(4)));
typedef int i32x4 __attribute__((ext_vector_type(4)));
typedef unsigned u32x2 __attribute__((ext_vector_type(2)));
constexpr int L_SC = 0, L_SEL = 131072, L_LUT = L_SEL + 8192, L_BS = L_LUT + 1024, L_END = L_BS + 1024 + 64, L_QP = L_END;
constexpr int VST = 288;
DEV f32x16 MF32(bf16x8 a, bf16x8 b, f32x16 c) { return __builtin_amdgcn_mfma_f32_32x32x16_bf16(a, b, c, 0, 0, 0); }
DEV f32x4 MF16(bf16x8 a, bf16x8 b, f32x4 c) { return __builtin_amdgcn_mfma_f32_16x16x32_bf16(a, b, c, 0, 0, 0); }
DEV f32x4 MF8(long a, long b, f32x4 c) { return __builtin_amdgcn_mfma_f32_16x16x32_fp8_fp8(a, b, c, 0, 0, 0); }
DEV long pack64(unsigned lo, unsigned hi) { return (long)(((unsigned long long)hi << 32) | (unsigned long long)lo); }
typedef __bf16 bf16x2v __attribute__((ext_vector_type(2)));
DEV unsigned fp8x2_to_bf16x2(unsigned src, bool hiword) { return hiword ? __builtin_bit_cast(unsigned, __builtin_amdgcn_cvt_scalef32_pk_bf16_fp8(src, 1.0f, true)) : __builtin_bit_cast(unsigned, __builtin_amdgcn_cvt_scalef32_pk_bf16_fp8(src, 1.0f, false)); }
DEV int wave_total(int v) {
    v += __builtin_amdgcn_update_dpp(0, v, 0xB1, 0xF, 0xF, true);
    v += __builtin_amdgcn_update_dpp(0, v, 0x4E, 0xF, 0xF, true);
    v += __builtin_amdgcn_update_dpp(0, v, 0x141, 0xF, 0xF, true);
    v += __builtin_amdgcn_update_dpp(0, v, 0x140, 0xF, 0xF, true);
    return __builtin_amdgcn_readlane(v, 0) + __builtin_amdgcn_readlane(v, 16) + __builtin_amdgcn_readlane(v, 32) + __builtin_amdgcn_readlane(v, 48);
}
DEV int wave_incl_scan(int v) {
    int x = v;
    x += __builtin_amdgcn_update_dpp(0, v, 0x111, 0xF, 0xF, true);
    x += __builtin_amdgcn_update_dpp(0, v, 0x112, 0xF, 0xF, true);
    x += __builtin_amdgcn_update_dpp(0, v, 0x113, 0xF, 0xF, true);
    x += __builtin_amdgcn_update_dpp(0, x, 0x114, 0xF, 0xE, true);
    x += __builtin_amdgcn_update_dpp(0, x, 0x118, 0xF, 0xC, true);
    x += __builtin_amdgcn_update_dpp(0, x, 0x142, 0xA, 0xF, true);
    x += __builtin_amdgcn_update_dpp(0, x, 0x143, 0xC, 0xF, true);
    return x;
}
template <int OFF>
DEV void vtr16(const LAS char* const (&ad)[8], s16x4 (&lo)[8], s16x4 (&hi)[8]) {
    long r0, r1, r2, r3, r4, r5, r6, r7, r8, r9, r10, r11, r12, r13, r14, r15;
    asm volatile("ds_read_b64_tr_b16 %0, %16 offset:%24\n\tds_read_b64_tr_b16 %1, %16 offset:%25\n\tds_read_b64_tr_b16 %2, %17 offset:%24\n\tds_read_b64_tr_b16 %3, %17 offset:%25\n\t"
                 "ds_read_b64_tr_b16 %4, %18 offset:%24\n\tds_read_b64_tr_b16 %5, %18 offset:%25\n\tds_read_b64_tr_b16 %6, %19 offset:%24\n\tds_read_b64_tr_b16 %7, %19 offset:%25\n\t"
                 "ds_read_b64_tr_b16 %8, %20 offset:%24\n\tds_read_b64_tr_b16 %9, %20 offset:%25\n\tds_read_b64_tr_b16 %10, %21 offset:%24\n\tds_read_b64_tr_b16 %11, %21 offset:%25\n\t"
                 "ds_read_b64_tr_b16 %12, %22 offset:%24\n\tds_read_b64_tr_b16 %13, %22 offset:%25\n\tds_read_b64_tr_b16 %14, %23 offset:%24\n\tds_read_b64_tr_b16 %15, %23 offset:%25\n\ts_waitcnt lgkmcnt(0)"
                 : "=&v"(r0), "=&v"(r1), "=&v"(r2), "=&v"(r3), "=&v"(r4), "=&v"(r5), "=&v"(r6), "=&v"(r7), "=&v"(r8), "=&v"(r9), "=&v"(r10), "=&v"(r11), "=&v"(r12), "=&v"(r13), "=&v"(r14), "=&v"(r15)
                 : "v"(ad[0]), "v"(ad[1]), "v"(ad[2]), "v"(ad[3]), "v"(ad[4]), "v"(ad[5]), "v"(ad[6]), "v"(ad[7]), "n"(OFF), "n"(OFF + 4096)
                 : "memory");
    lo[0] = __builtin_bit_cast(s16x4, r0); hi[0] = __builtin_bit_cast(s16x4, r1); lo[1] = __builtin_bit_cast(s16x4, r2); hi[1] = __builtin_bit_cast(s16x4, r3);
    lo[2] = __builtin_bit_cast(s16x4, r4); hi[2] = __builtin_bit_cast(s16x4, r5); lo[3] = __builtin_bit_cast(s16x4, r6); hi[3] = __builtin_bit_cast(s16x4, r7);
    lo[4] = __builtin_bit_cast(s16x4, r8); hi[4] = __builtin_bit_cast(s16x4, r9); lo[5] = __builtin_bit_cast(s16x4, r10); hi[5] = __builtin_bit_cast(s16x4, r11);
    lo[6] = __builtin_bit_cast(s16x4, r12); hi[6] = __builtin_bit_cast(s16x4, r13); lo[7] = __builtin_bit_cast(s16x4, r14); hi[7] = __builtin_bit_cast(s16x4, r15);
}
template <int NC>
DEV void bisect256(LAS unsigned* row, int lane, unsigned& T, int& need, LAS int* selw, const LAS unsigned char* lut, int t) {
    u32x4 k[NC];
#pragma unroll
    for (int c = 0; c < NC; ++c) k[c] = *(const LAS u32x4*)(row + 256 * c + 4 * lane);
    unsigned prefix = 0u; bool exact = false;
    int bit = 31, clo = 0, chi = 0, lcnt = 0;
    {
        unsigned mxk = 0u;
#pragma unroll
        for (int c = 0; c < NC; ++c) mxk = max(max(mxk, max(k[c].x, k[c].y)), max(k[c].z, k[c].w));
        mxk = max(mxk, (unsigned)__builtin_amdgcn_update_dpp(0, (int)mxk, 0xB1, 0xF, 0xF, true)); mxk = max(mxk, (unsigned)__builtin_amdgcn_update_dpp(0, (int)mxk, 0x4E, 0xF, 0xF, true));
        mxk = max(mxk, (unsigned)__builtin_amdgcn_update_dpp(0, (int)mxk, 0x141, 0xF, 0xF, true)); mxk = max(mxk, (unsigned)__builtin_amdgcn_update_dpp(0, (int)mxk, 0x140, 0xF, 0xF, true));
        unsigned e9 = max(max((unsigned)__builtin_amdgcn_readlane((int)mxk, 0), (unsigned)__builtin_amdgcn_readlane((int)mxk, 16)), max((unsigned)__builtin_amdgcn_readlane((int)mxk, 32), (unsigned)__builtin_amdgcn_readlane((int)mxk, 48))) >> 23;
        for (int step = 0; step < 6 && e9 > 0u; ++step, --e9) {
            const unsigned cand = e9 << 23;
            int cnt = 0;
#pragma unroll
            for (int c = 0; c < NC; ++c) { cnt += (k[c].x >= cand) ? 1 : 0; cnt += (k[c].y >= cand) ? 1 : 0; cnt += (k[c].z >= cand) ? 1 : 0; cnt += (k[c].w >= cand) ? 1 : 0; }
            const int tot = wave_total(cnt);
            if (tot >= 256) { prefix = cand; bit = 22; exact = (tot == 256); clo = tot; lcnt = cnt; break; }
            chi = tot;
        }
    }
    if (!exact && bit == 22) {
        unsigned lo = prefix, width = 1u << 23;
        int side = 0;
        while (width > 1u) {
            unsigned off = width >> 1;
            if (side > -2 && side < 2) off = (unsigned)((float)width * (((float)clo - 256.5f) * __builtin_amdgcn_rcpf((float)(clo - chi))));
            else side = 0;
            off = min(max(off, 1u), width - 1u);
            const unsigned cand = lo + off;
            int cnt = 0;
#pragma unroll
            for (int c = 0; c < NC; ++c) { cnt += (k[c].x >= cand) ? 1 : 0; cnt += (k[c].y >= cand) ? 1 : 0; cnt += (k[c].z >= cand) ? 1 : 0; cnt += (k[c].w >= cand) ? 1 : 0; }
            const int tot = wave_total(cnt);
            if (tot == 256) { lo = cand; exact = true; lcnt = cnt; break; }
            if (tot > 256) { lo = cand; width -= off; clo = tot; side = side > 0 ? side + 1 : 1; }
            else { width = off; chi = tot; side = side < 0 ? side - 1 : -1; }
        }
        prefix = lo;
        bit = -1;
    }
    if (!exact)
    for (; bit >= 0; --bit) {
        const unsigned cand = prefix | (1u << bit);
        int cnt = 0;
#pragma unroll
        for (int c = 0; c < NC; ++c) { cnt += (k[c].x >= cand) ? 1 : 0; cnt += (k[c].y >= cand) ? 1 : 0; cnt += (k[c].z >= cand) ? 1 : 0; cnt += (k[c].w >= cand) ? 1 : 0; }
        const int tot = wave_total(cnt);
        if (tot >= 256) prefix = cand;
        if (tot == 256) { exact = true; lcnt = cnt; break; }
    }
    if (exact) {
        T = prefix - 1u; need = 0;
        const int cnt = lcnt;
        LAS int* wp = selw + (wave_incl_scan(cnt) - cnt);
        LAS int* const dummy = (LAS int*)row + lane;
        const int i4 = 4 * lane;
#pragma unroll
        for (int c = 0; c < NC; ++c) {
#pragma unroll
            for (int e = 0; e < 4; ++e) {
                const bool f = k[c][e] >= prefix;
                *(f ? wp : dummy) = 256 * c + e + i4;
                wp += f ? 1 : 0;
            }
        }
        int ent[4];
#pragma unroll
        for (int i = 0; i < 4; ++i) ent[i] = selw[lane + 64 * i];
        int bk[4];
#pragma unroll
        for (int i = 0; i < 4; ++i) bk[i] = (int)lut[min(t - ent[i], 1023)];
#pragma unroll
        for (int i = 0; i < 4; ++i) selw[lane + 64 * i] = ent[i] | (bk[i] << 21);
    }
    else {
        int cnt = 0;
#pragma unroll
        for (int c = 0; c < NC; ++c) { cnt += (k[c].x > prefix) ? 1 : 0; cnt += (k[c].y > prefix) ? 1 : 0; cnt += (k[c].z > prefix) ? 1 : 0; cnt += (k[c].w > prefix) ? 1 : 0; }
        T = prefix; need = 256 - wave_total(cnt);
    }
}
}

DEV void phase3_dsa_fast(CP p, int l, int bid, int nb, char* lds_) {
    using namespace dsa;
    using nsa::vtr; using nsa::cvtpk; using nsa::ex2;
    LAS char* lds = (LAS char*)lds_;
    const int tid = tidx(), wid = tid >> 6, lane = tid & 63, r32 = lane & 31, hi = lane >> 5;
    LAS unsigned* sc = (LAS unsigned*)(lds + L_SC);
    LAS int* selw = (LAS int*)(lds + L_SEL) + wid * 256;
    LAS unsigned char* lut = (LAS unsigned char*)(lds + L_LUT);
    LAS float* bs = (LAS float*)(lds + L_BS);
    for (int e = tid; e < 1024; e += NTHREADS) lut[e] = (unsigned char)t5_bucket(e);
    if (tid < 264) bs[tid] = tid < 256 ? p.rel_bias[(tid >> 3) * 16 + (tid & 7)] * nsa::LOG2E - nsa::M0 : -INFINITY;
#define DSA_QPRE(it_) do { const int j_ = (it_) / 256, rem_ = (it_) % 256, b_ = rem_ & 7, a_ = rem_ >> 3; \
        const int tq_ = (j_ & 1) ? 32 * (15 - j_) + a_ : 32 * (15 - j_) + 31 - a_; \
        const bf16_t* src_ = p.P + ((size_t)b_ * SEQ + tq_ * 8 + wid) * DP; \
        __builtin_amdgcn_global_load_lds((const unsigned*)(src_ + C_QI + lane * 8), (LAS unsigned*)(lds + L_QP + wid * 1024), 16, 0, 0); \
          \
        __builtin_amdgcn_global_load_lds((const unsigned*)(src_ + (size_t)(((lane >> 2) & 7) - wid) * DP + C_WI + (lane & 3) * 2), (LAS unsigned*)(lds + L_QP + 8192), 4, 0, 0); } while (0)
    if (bid < NBATCH * 512) DSA_QPRE(bid);
    __syncthreads();
    for (int it = bid; it < NBATCH * 512; it += nb) {
        const int j = it / 256, rem = it % 256, b = rem & 7, a = rem >> 3;
        const int tq = (j & 1) ? 32 * (15 - j) + a : 32 * (15 - j) + 31 - a;
        const int t0 = tq * 8;
        const bf16_t* Pb = p.P + (size_t)b * SEQ * DP;
#ifdef DSA_REP_A
        for (int repA = 0; repA < 2; ++repA)
#endif
        if (t0 + 8 > 256) {
            const int query = 2 * ((r32 >> 2) & 1) + (r32 >> 4), head = 4 * ((r32 >> 3) & 1) + (r32 & 3);
            const LAS char* qp = lds + L_QP;
            bf16x8 aq[2][4];
#pragma unroll
            for (int mt = 0; mt < 2; ++mt)
#pragma unroll
                for (int ks = 0; ks < 4; ++ks) aq[mt][ks] = *(const LAS bf16x8*)(qp + (4 * mt + query) * 1024 + head * 128 + (16 * ks + 8 * hi) * 2);
            float wq[4][8];
#pragma unroll
            for (int qq = 0; qq < 4; ++qq) {
                const u32x4 wr = *(const LAS u32x4*)(qp + 8192 + (4 * (qq >> 1) + 2 * hi + (qq & 1)) * 16);
#pragma unroll
                for (int h = 0; h < 8; ++h) wq[qq][h] = ((h & 1) ? __uint_as_float(wr[h >> 1] & 0xFFFF0000u) : __uint_as_float(wr[h >> 1] << 16)) * (0.35355339059327373f * 0.125f);
            }
            const int NT = (t0 + 7) / 32 + 1;
            LAS unsigned* srow0 = sc + (2 * hi) * 4096 + r32;
            const bf16_t* kbase = p.Ki + (size_t)b * SEQ * 64 + lane * 8;
            for (int g = 0; wid + 32 * g < NT; ++g) {
                bf16x8 bk[4][4];
#pragma unroll
                for (int i = 0; i < 4; ++i) { const int jt = min(wid + 32 * g + 8 * i, NT - 1);
#pragma unroll
                    for (int ks = 0; ks < 4; ++ks) bk[i][ks] = *(const bf16x8*)(kbase + ((size_t)jt * 4 + ks) * 512); }
                asm volatile("" ::: "memory");
#pragma unroll
                for (int i = 0; i < 4; ++i) {
                    const int jt = wid + 32 * g + 8 * i;
                    if (jt >= NT) break;
#pragma unroll
                    for (int mt = 0; mt < 2; ++mt) {
                        f32x16 acc;
#pragma unroll
                        for (int r = 0; r < 16; ++r) acc[r] = 0.f;
#pragma unroll
                        for (int ks = 0; ks < 4; ++ks) acc = MF32(aq[mt][ks], bk[i][ks], acc);
                        float s0 = 0.f, s1 = 0.f;
#pragma unroll
                        for (int h = 0; h < 8; ++h) { s0 = fmaf(wq[2 * mt][h], __int_as_float(max(__float_as_int(acc[h]), 0)), s0); asm("" : "+v"(s0)); s1 = fmaf(wq[2 * mt + 1][h], __int_as_float(max(__float_as_int(acc[8 + h]), 0)), s1); }
                        srow0[(4 * mt) * 4096 + 32 * jt] = f2key(s0); srow0[(4 * mt + 1) * 4096 + 32 * jt] = f2key(s1);
                    }
                }
            }
        }
        __syncthreads();
        const int t = t0 + wid, n = t + 1;
        u32x4 qraw[2]; u32x2 zraw[4];
        {
            const bf16_t* prow_ = Pb + (size_t)t * DP; const int col_ = min(lane & 15, 7), kq_ = lane >> 4;
#pragma unroll
            for (int hh = 0; hh < 2; ++hh) qraw[hh] = *(const u32x4*)(prow_ + C_QA + col_ * 64 + 16 * kq_ + 8 * hh);
#pragma unroll
            for (int m4 = 0; m4 < 4; ++m4) zraw[m4] = *(const u32x2*)(prow_ + C_ZA + col_ * 64 + 16 * m4 + 4 * kq_);
            asm volatile("" ::: "memory");
        }
        LAS unsigned* row = sc + wid * 4096;
        int nsel;
#ifdef DSA_REP_B
        for (int repB = 0; repB < 2; ++repB)
#endif
        if (n <= 256) { nsel = n; for (int i = lane; i < 256; i += 64) selw[i] = i < n ? (i | ((int)lut[min(t - i, 1023)] << 21)) : (32 << 21); }
        else {
            nsel = 256;
            const int ncls = (n + 511) >> 9;
            const int nrc = ncls << 9;
            for (int i = n + lane; i < nrc; i += 64) row[i] = 0u;
            unsigned T; int need;
            switch (ncls) {
                case 1: bisect256<2>(row, lane, T, need, selw, lut, t); break;
                case 2: bisect256<4>(row, lane, T, need, selw, lut, t); break;
                case 3: bisect256<6>(row, lane, T, need, selw, lut, t); break;
                case 4: bisect256<8>(row, lane, T, need, selw, lut, t); break;
                case 5: bisect256<10>(row, lane, T, need, selw, lut, t); break;
                case 6: bisect256<12>(row, lane, T, need, selw, lut, t); break;
                case 7: bisect256<14>(row, lane, T, need, selw, lut, t); break;
                default: bisect256<16>(row, lane, T, need, selw, lut, t); break;
            }
            int base = 0, eqseen = 0;
            const u64 lt = (lane == 0) ? 0ull : (~0ull >> (64 - lane));
            if (need != 0)
            for (int i0 = 0; i0 < n; i0 += 64) {
                const int i = i0 + lane; const bool v = i < n; const unsigned k = v ? row[i] : 0u;
                const bool gt = v && k > T, eq = v && k == T;
                const u64 beq = __ballot(eq); const int eqrank = eqseen + __popcll(beq & lt);
                const bool take = gt || (eq && eqrank < need);
                const u64 bt = __ballot(take); const int pos = base + __popcll(bt & lt);
                if (take) selw[pos] = i | ((int)lut[min(t - i, 1023)] << 21);
                base += __popcll(bt); eqseen += __popcll(beq);
            }
        }
#ifdef DSA_REP_C
        for (int repC = 0; repC < 2; ++repC)
#endif
        {
            const int col = lane & 15, kq = lane >> 4;
            const bf16_t* prow = Pb + (size_t)t * DP;
            long qb8[4];
            {
                const bool act = col < 8;
                float xq[2][8]; float ss = 0.f;
#pragma unroll
                for (int hh = 0; hh < 2; ++hh) {
                    uint4 raw = {0u, 0u, 0u, 0u};
                    if (act) { raw.x = qraw[hh][0]; raw.y = qraw[hh][1]; raw.z = qraw[hh][2]; raw.w = qraw[hh][3]; }
                    unpack8g(raw, xq[hh]);
#pragma unroll
                    for (int jx = 0; jx < 8; ++jx) ss = fmaf(xq[hh][jx], xq[hh][jx], ss);
                }
                ss += __shfl_xor(ss, 16); ss += __shfl_xor(ss, 32);
                const float rq = rsqrtf(ss * (1.f / 64.f) + EPS);
#pragma unroll
                for (int ks = 0; ks < 4; ++ks) {
                    const int hh = ks & 1;
                    const float* gq = p.q_norm_a + l * 64 + 16 * kq + 8 * hh;
                    const float4 g0 = *(const float4*)gq, g1 = *(const float4*)(gq + 4);
                    int w0 = __builtin_amdgcn_cvt_pk_fp8_f32(xq[hh][0] * rq * g0.x, xq[hh][1] * rq * g0.y, 0, false);
                    w0 = __builtin_amdgcn_cvt_pk_fp8_f32(xq[hh][2] * rq * g0.z, xq[hh][3] * rq * g0.w, w0, true);
                    int w1 = __builtin_amdgcn_cvt_pk_fp8_f32(xq[hh][4] * rq * g1.x, xq[hh][5] * rq * g1.y, 0, false);
                    w1 = __builtin_amdgcn_cvt_pk_fp8_f32(xq[hh][6] * rq * g1.z, xq[hh][7] * rq * g1.w, w1, true);
                    qb8[ks] = (act && (ks >> 1) == (col >> 2)) ? pack64((unsigned)w0, (unsigned)w1) : 0l;
                }
            }
#ifndef DSA_REP_C
            if (it + nb < NBATCH * 512) DSA_QPRE(it + nb);
#endif
            const unsigned char* Kab = (const unsigned char*)p.Ka + (size_t)b * SEQ * 128; const unsigned char* Vab = (const unsigned char*)p.Va + (size_t)b * SEQ * 128;
            unsigned Ppk[16][2];
            float sum = 0.f;
            const LAS float* bsh = bs + (col & 7);
            const int wr_r = lane >> 3, wr_c = lane & 7;
            u32x4 vrA[8], vrB[8];
            u32x4 kA[2][2], kB[2][2];
#define DSA_KLOAD(dst, g2_) do { int sk0_ = selw[16 * (2 * (g2_)) + col], sk1_ = selw[16 * (2 * (g2_) + 1) + col]; \
                asm volatile("" : "+v"(sk0_), "+v"(sk1_)); \
                _Pragma("unroll") for (int tt = 0; tt < 2; ++tt) { const int s0_ = (tt ? sk1_ : sk0_) & 0xFFFF; \
                _Pragma("unroll") for (int pp = 0; pp < 2; ++pp) dst[tt][pp] = *(const u32x4*)(Kab + (size_t)s0_ * 128 + 64 * pp + 16 * kq); } } while (0)
#define DSA_KMUL(src, g2_) do { i32x4 svs[2]; svs[0] = *(const LAS i32x4*)(selw + 16 * (2 * (g2_)) + 4 * kq); svs[1] = *(const LAS i32x4*)(selw + 16 * (2 * (g2_) + 1) + 4 * kq);     \
                f32x4 accA[2], accB[2]; \
                _Pragma("unroll") for (int tt = 0; tt < 2; ++tt) { accA[tt] = (f32x4){0.f, 0.f, 0.f, 0.f}; accB[tt] = (f32x4){0.f, 0.f, 0.f, 0.f}; \
                    accA[tt] = MF8(pack64(src[tt][0][0], src[tt][0][1]), qb8[0], accA[tt]); accB[tt] = MF8(pack64(src[tt][1][0], src[tt][1][1]), qb8[2], accB[tt]); \
                    accA[tt] = MF8(pack64(src[tt][0][2], src[tt][0][3]), qb8[1], accA[tt]); accB[tt] = MF8(pack64(src[tt][1][2], src[tt][1][3]), qb8[3], accB[tt]); } \
                float bv_[2][4]; \
                _Pragma("unroll") for (int tt = 0; tt < 2; ++tt) _Pragma("unroll") for (int i = 0; i < 4; ++i) bv_[tt][i] = *(const LAS float*)((const LAS char*)bsh + (svs[tt][i] >> 16)); \
                asm volatile("" : "+v"(bv_[0][0]), "+v"(bv_[0][1]), "+v"(bv_[0][2]), "+v"(bv_[0][3]), "+v"(bv_[1][0]), "+v"(bv_[1][1]), "+v"(bv_[1][2]), "+v"(bv_[1][3])); \
                _Pragma("unroll") for (int tt = 0; tt < 2; ++tt) { const int kt_ = 2 * (g2_) + tt; float e_[4]; \
                    _Pragma("unroll") for (int i = 0; i < 4; ++i) { e_[i] = ex2(fmaf(accA[tt][i] + accB[tt][i], nsa::C2, bv_[tt][i])); sum += e_[i]; } \
                    Ppk[kt_][0] = cvtpk(e_[0], e_[1]); Ppk[kt_][1] = cvtpk(e_[2], e_[3]); } } while (0)
            u32x4 kC[2][2], kD[2][2];
            DSA_KLOAD(kA, 0); DSA_KLOAD(kB, 1); DSA_KLOAD(kC, 2); DSA_KLOAD(kD, 3);
            DSA_KMUL(kA, 0); DSA_KLOAD(kA, 4);
            DSA_KMUL(kB, 1); DSA_KLOAD(kB, 5);
            DSA_KMUL(kC, 2); DSA_KLOAD(kC, 6);
            DSA_KMUL(kD, 3); DSA_KLOAD(kD, 7);
#define DSA_VLOAD(dst, u_) do { int sx_[8]; _Pragma("unroll") for (int i = 0; i < 8; ++i) sx_[i] = selw[64 * (u_) + wr_r + 8 * i]; \
                asm volatile("" : "+v"(sx_[0]), "+v"(sx_[1]), "+v"(sx_[2]), "+v"(sx_[3]), "+v"(sx_[4]), "+v"(sx_[5]), "+v"(sx_[6]), "+v"(sx_[7]));     \
                _Pragma("unroll") for (int i = 0; i < 8; ++i) dst[i] = *(const u32x4*)(Vab + (size_t)(sx_[i] & 0xFFFF) * 128 + wr_c * 16); } while (0)
            DSA_KMUL(kA, 4);
            DSA_KMUL(kB, 5); DSA_VLOAD(vrA, 0);
            DSA_KMUL(kC, 6); DSA_VLOAD(vrB, 1);
            DSA_KMUL(kD, 7);
#undef DSA_KLOAD
#undef DSA_KMUL
            sum += __shfl_xor(sum, 16); sum += __shfl_xor(sum, 32);
            const float inv = 1.f / sum;
            f32x4 Og0[4], Og1[4];
#pragma unroll
            for (int mt = 0; mt < 4; ++mt) { Og0[mt] = (f32x4){0.f, 0.f, 0.f, 0.f}; Og1[mt] = (f32x4){0.f, 0.f, 0.f, 0.f}; }
            LAS char* vst = lds + L_SC + wid * 16384;
            const int q4 = (lane & 15) >> 2, p4 = lane & 3;
            const int swz = (4 * (kq & 1) + q4) << 1;
            const LAS char* vrd = vst + (4 * kq + q4) * 256 + (p4 & 1) * 8;
#define DSA_VSTAGE(src) do { _Pragma("unroll") for (int i = 0; i < 8; ++i) { const int rloc = wr_r + 8 * i; \
                _Pragma("unroll") for (int h = 0; h < 2; ++h) { u32x4 w; w.x = fp8x2_to_bf16x2(src[i][2 * h], false); w.y = fp8x2_to_bf16x2(src[i][2 * h], true); w.z = fp8x2_to_bf16x2(src[i][2 * h + 1], false); w.w = fp8x2_to_bf16x2(src[i][2 * h + 1], true); \
                    *(LAS u32x4*)(vst + rloc * 256 + (((2 * wr_c + h) ^ ((rloc & 7) << 1)) << 4)) = w; } \
                if (i & 1) __builtin_amdgcn_sched_barrier(0); } } while (0)
#define DSA_VMUL(u) do { _Pragma("unroll") for (int h2 = 0; h2 < 2; ++h2) { union { unsigned uu[4]; bf16x8 v; } pb; \
                pb.uu[0] = Ppk[4 * (u) + 2 * h2][0]; pb.uu[1] = Ppk[4 * (u) + 2 * h2][1]; pb.uu[2] = Ppk[4 * (u) + 2 * h2 + 1][0]; pb.uu[3] = Ppk[4 * (u) + 2 * h2 + 1][1]; \
                s16x4 tlo[8], thi[8]; if (h2 == 0) vtr16<0>(vad, tlo, thi); else vtr16<8192>(vad, tlo, thi); \
                _Pragma("unroll") for (int mt = 0; mt < 8; ++mt) { \
                    const bf16x8 vf = __builtin_shufflevector(tlo[mt], thi[mt], 0, 1, 2, 3, 4, 5, 6, 7); \
                    if (mt < 4) Og0[mt] = MF16(vf, pb.v, Og0[mt]); else Og1[mt - 4] = MF16(vf, pb.v, Og1[mt - 4]); } } } while (0)
            const LAS char* vad[8];
#pragma unroll
            for (int mt = 0; mt < 8; ++mt) vad[mt] = vrd + (((2 * mt + (p4 >> 1)) ^ swz) << 4);
            DSA_VSTAGE(vrA); DSA_VLOAD(vrA, 2); DSA_VMUL(0);
            DSA_VSTAGE(vrB); DSA_VLOAD(vrB, 3); DSA_VMUL(1);
            DSA_VSTAGE(vrA); DSA_VMUL(2);
            DSA_VSTAGE(vrB); DSA_VMUL(3);
#undef DSA_VLOAD
#undef DSA_VSTAGE
#undef DSA_VMUL
            __builtin_amdgcn_s_waitcnt(0x0F70);
            if (col < 8) {
                const bf16_t* zrow = prow + C_ZA + col * 64; bf16_t* yrow = p.H + (size_t)(b * SEQ + t) * DM + col * 64;
#pragma unroll
                for (int m4 = 0; m4 < 4; ++m4) {
                    const int d = 16 * m4 + 4 * kq;
                    const f32x4 oa = Og0[m4], ob = Og1[m4]; const bool gsel = (col >> 2) != 0;
                    f32x4 o; o[0] = gsel ? ob[0] : oa[0]; o[1] = gsel ? ob[1] : oa[1]; o[2] = gsel ? ob[2] : oa[2]; o[3] = gsel ? ob[3] : oa[3];
                    uint2 zz; zz.x = zraw[m4][0]; zz.y = zraw[m4][1];
                    const float z0 = __uint_as_float(zz.x << 16), z1 = __uint_as_float(zz.x & 0xFFFF0000u), z2 = __uint_as_float(zz.y << 16), z3 = __uint_as_float(zz.y & 0xFFFF0000u);
                    uint2 y; y.x = pk2(o[0] * inv * silu(z0), o[1] * inv * silu(z1)); y.y = pk2(o[2] * inv * silu(z2), o[3] * inv * silu(z3));
                    *(uint2*)(yrow + d) = y;
                }
            }
        }
        asm volatile("s_waitcnt lgkmcnt(0)" ::: "memory"); __builtin_amdgcn_s_barrier(); asm volatile("" ::: "memory");
    }
}


namespace p2 {
typedef short bf16x8 __attribute__((ext_vector_type(8)));
typedef float f32x4 __attribute__((ext_vector_type(4)));
typedef unsigned u32x2 __attribute__((ext_vector_type(2)));
typedef unsigned u32x4 __attribute__((ext_vector_type(4)));
DEV f32x4 MF16(bf16x8 a, bf16x8 b, f32x4 c) { return __builtin_amdgcn_mfma_f32_16x16x32_bf16(a, b, c, 0, 0, 0); }
DEV void unpack8(const uint4 v, float (&x)[8]) {
    x[0] = __uint_as_float(v.x << 16); x[1] = __uint_as_float(v.x & 0xFFFF0000u); x[2] = __uint_as_float(v.y << 16); x[3] = __uint_as_float(v.y & 0xFFFF0000u);
    x[4] = __uint_as_float(v.z << 16); x[5] = __uint_as_float(v.z & 0xFFFF0000u); x[6] = __uint_as_float(v.w << 16); x[7] = __uint_as_float(v.w & 0xFFFF0000u);
}
DEV void norm8(bf16_t* ptr, const float* __restrict__ g, float extra = 1.f) {
    float x[8]; unpack8(*(const uint4*)ptr, x);
    float ss = 0.f;
#pragma unroll
    for (int j = 0; j < 8; ++j) ss = fmaf(x[j], x[j], ss);
    ss += __shfl_xor(ss, 1); ss += __shfl_xor(ss, 2); ss += __shfl_xor(ss, 4);
    const float r = rsqrtf(ss * (1.f / 64.f) + EPS) * extra;
    const float4 g0 = *(const float4*)g, g1 = *(const float4*)(g + 4);
    uint4 o; o.x = pk2(x[0] * r * g0.x, x[1] * r * g0.y); o.y = pk2(x[2] * r * g0.z, x[3] * r * g0.w); o.z = pk2(x[4] * r * g1.x, x[5] * r * g1.y); o.w = pk2(x[6] * r * g1.z, x[7] * r * g1.w);
    *(uint4*)ptr = o;
}
}

DEV void phase2_post_fast(CP p, int l, int bid, int nb, char* lds_) {
    using namespace p2;
    LAS char* lds = (LAS char*)lds_;
    const int tid = tidx(), wid = tid >> 6, lane = tid & 63, col = lane & 15, kq = lane >> 4;
    for (int tt = bid * NWAVES + wid; tt < NTOK / 16; tt += nb * NWAVES) {
        const int tok0 = tt * 16;
        {
            const int gsel = (lane >> 3) & 1;
            const int srcc = (lane < 16 ? C_KS : lane < 32 ? C_KW : lane < 48 ? C_VS : C_VW) + (lane & 15) * 8;
            const float* gp = (lane < 16 ? p.k_norm_slc : p.k_norm_win) + l * 64 + (lane & 7) * 8;
            float4 g0 = {1.f, 1.f, 1.f, 1.f}, g1 = {1.f, 1.f, 1.f, 1.f};
            if (lane < 32) { g0 = *(const float4*)gp; g1 = *(const float4*)(gp + 4); }
            const float gbias = p.b_gate_b[l * 24 + min(lane, 23)];
            bf16_t* dstb = (lane < 16 ? p.Ks : lane < 32 ? p.Kw : lane < 48 ? p.Vs : p.Vw);
            const int cch = lane & 7;
#pragma unroll 1
            for (int i0 = 0; i0 < 16; i0 += 8) {
                u32x4 xin[8], kiv[8]; unsigned graw[8];
#pragma unroll
                for (int i = 0; i < 8; ++i) {
                    const bf16_t* row = p.P + (size_t)(tok0 + i0 + i) * DP;
                    xin[i] = *(const u32x4*)(row + srcc);
                    kiv[i] = *(const u32x4*)(row + C_KI + (lane & 7) * 8);
                    graw[i] = (unsigned)row[C_GB + min(lane, 23)];
                }
#pragma unroll
                for (int i = 0; i < 8; ++i) {
                    bf16_t* row = p.P + (size_t)(tok0 + i0 + i) * DP;
                    const int tok = tok0 + i0 + i, bb = tok / SEQ, tt2 = tok % SEQ;
                    float x[8]; { uint4 xv; xv.x = xin[i][0]; xv.y = xin[i][1]; xv.z = xin[i][2]; xv.w = xin[i][3]; unpack8(xv, x); }
                    float ss = 0.f;
#pragma unroll
                    for (int j = 0; j < 8; ++j) ss = fmaf(x[j], x[j], ss);
                    ss += __shfl_xor(ss, 1); ss += __shfl_xor(ss, 2); ss += __shfl_xor(ss, 4);
                    const float r = (lane < 32) ? rsqrtf(ss * (1.f / 64.f) + EPS) : 1.f;
                    uint4 o; o.x = pk2(x[0] * r * g0.x, x[1] * r * g0.y); o.y = pk2(x[2] * r * g0.z, x[3] * r * g0.w); o.z = pk2(x[4] * r * g1.x, x[5] * r * g1.y); o.w = pk2(x[6] * r * g1.z, x[7] * r * g1.w);
                    const int keyl = tt2 & 63;
                    const int imgoff = (lane < 32) ? (cch * 512 + keyl * 8) : ((cch >> 2) * 2048 + keyl * 32 + (cch & 3) * 8);
                    *(uint4*)(dstb + (size_t)(bb * 2 + gsel) * SEQ * 64 + (size_t)(tt2 >> 6) * 4096 + imgoff) = o;
                    if (lane < 8) *(uint4*)(p.Ki + ((size_t)(tok >> 5) * 4 + (lane >> 1)) * 512 + ((lane & 1) * 32 + (tok & 31)) * 8) = *(const uint4*)&kiv[i];
                    if (lane < 24) row[C_GB + lane] = f2bf(sigmoidf_(__uint_as_float(graw[i] << 16) + gbias));
                }
            }
        }
        bf16x8 af[4];
        {
            const bf16_t* crow = p.P + (size_t)(tok0 + col) * DP + C_CKV + 8 * kq;
            float x[4][8]; float ss = 0.f;
#pragma unroll
            for (int ks = 0; ks < 4; ++ks) { unpack8(*(const uint4*)(crow + 32 * ks), x[ks]);
#pragma unroll
                for (int j = 0; j < 8; ++j) ss = fmaf(x[ks][j], x[ks][j], ss); }
            ss += __shfl_xor(ss, 16); ss += __shfl_xor(ss, 32);
            const float r = rsqrtf(ss * (1.f / 128.f) + EPS);
#pragma unroll
            for (int ks = 0; ks < 4; ++ks) {
                const float* gk = p.kv_norm_a + l * 128 + 32 * ks + 8 * kq;
                union { unsigned u[4]; bf16x8 v; } pk;
#pragma unroll
                for (int j = 0; j < 4; ++j) pk.u[j] = pk2(x[ks][2 * j] * r * gk[2 * j], x[ks][2 * j + 1] * r * gk[2 * j + 1]);
                af[ks] = pk.v;
            }
        }
        const bf16_t* wkv = p.wt_kvup + (size_t)l * 256 * 128;
#pragma unroll 1
        for (int h4 = 0; h4 < 4; ++h4) {
            f32x4 acc[4];
            bf16x8 wf[4][4];
#pragma unroll
            for (int nt = 0; nt < 4; ++nt)
#pragma unroll
                for (int ks = 0; ks < 4; ++ks) wf[nt][ks] = *(const bf16x8*)(wkv + (size_t)(h4 * 64 + nt * 16 + col) * 128 + 32 * ks + 8 * kq);
            asm volatile("" ::: "memory");
#pragma unroll
            for (int nt = 0; nt < 4; ++nt) {
                acc[nt] = (f32x4){0.f, 0.f, 0.f, 0.f};
#pragma unroll
                for (int ks = 0; ks < 4; ++ks) acc[nt] = MF16(wf[nt][ks], af[ks], acc[nt]);
            }
            float rr = 1.f;
            if (h4 < 2) {
                float s2 = 0.f;
#pragma unroll
                for (int nt = 0; nt < 4; ++nt)
#pragma unroll
                    for (int i = 0; i < 4; ++i) s2 = fmaf(acc[nt][i], acc[nt][i], s2);
                s2 += __shfl_xor(s2, 16); s2 += __shfl_xor(s2, 32);
                rr = rsqrtf(s2 * (1.f / 64.f) + EPS);
            }
            unsigned char* dst = (unsigned char*)(h4 < 2 ? p.Ka : p.Va) + (size_t)(tok0 + col) * 128 + (h4 & 1) * 64 + 4 * kq;
#pragma unroll
            for (int nt = 0; nt < 4; ++nt) {
                float4 gn = {1.f, 1.f, 1.f, 1.f};
                if (h4 < 2) gn = *(const float4*)(p.k_norm_a + l * 64 + 16 * nt + 4 * kq);
                int w8 = __builtin_amdgcn_cvt_pk_fp8_f32(acc[nt][0] * rr * gn.x, acc[nt][1] * rr * gn.y, 0, false);
                w8 = __builtin_amdgcn_cvt_pk_fp8_f32(acc[nt][2] * rr * gn.z, acc[nt][3] * rr * gn.w, w8, true);
                *(int*)(dst + 16 * nt) = w8;
            }
        }
    }
    LAS char* h1buf = lds;
    LAS float* ssbuf = (LAS float*)(lds + 4096);
    for (int it = bid; it < NBATCH * 2 * 2 * 8; it += nb) {
        const int rg = it & 7, kv = (it >> 3) & 1, g = (it >> 4) & 1, b = it >> 5;
        const int mtile = wid >> 2, nt = wid & 3;
        const int c = rg * 32 + mtile * 16 + col, cc = min(c, 254);
        const bf16_t* xb = p.P + (size_t)(b * SEQ + 16 * cc) * DP + (kv ? C_VC : C_KC) + g * 64 + 8 * kq;
        const bf16_t* wb = (kv ? p.wt_c1v : p.wt_c1k) + (size_t)l * 64 * 2048 + (size_t)(nt * 16 + col) * 2048 + 8 * kq;
        f32x4 acc = {0.f, 0.f, 0.f, 0.f};
#pragma unroll 1
        for (int k0 = 0; k0 < 64; k0 += 16) {
            bf16x8 xf[16], wf[16];
#pragma unroll
            for (int j = 0; j < 16; ++j) { const int ks = k0 + j; xf[j] = *(const bf16x8*)(xb + (size_t)(ks >> 1) * DP + 32 * (ks & 1)); wf[j] = *(const bf16x8*)(wb + 32 * ks); }
            asm volatile("" ::: "memory");
#pragma unroll
            for (int j = 0; j < 16; ++j) acc = MF16(wf[j], xf[j], acc);
        }
        {
            const float4 cb = *(const float4*)((kv ? p.cbias_v : p.cbias_k) + l * 64 + 16 * nt + 4 * kq);
            u32x2 o; o.x = pk2(gelu_tanh(acc[0] + cb.x), gelu_tanh(acc[1] + cb.y)); o.y = pk2(gelu_tanh(acc[2] + cb.z), gelu_tanh(acc[3] + cb.w));
            *(LAS u32x2*)(h1buf + (mtile * 16 + col) * 128 + (16 * nt + 4 * kq) * 2) = o;
        }
        __syncthreads();
        f32x4 acc2 = {0.f, 0.f, 0.f, 0.f};
        const bf16_t* w2 = (kv ? p.wt_c2v : p.wt_c2k) + (size_t)l * 64 * 64 + (size_t)(16 * nt + col) * 64 + 8 * kq;
#pragma unroll
        for (int s = 0; s < 2; ++s) {
            const bf16x8 hf = *(const LAS bf16x8*)(h1buf + (mtile * 16 + col) * 128 + (32 * s + 8 * kq) * 2);
            const bf16x8 wf = *(const bf16x8*)(w2 + 32 * s);
            acc2 = MF16(wf, hf, acc2);
        }
        float rr = 1.f;
        {
            float s2 = (acc2[0] * acc2[0] + acc2[1] * acc2[1]) + (acc2[2] * acc2[2] + acc2[3] * acc2[3]);
            s2 += __shfl_xor(s2, 16); s2 += __shfl_xor(s2, 32);
            if (kq == 0) ssbuf[(mtile * 4 + nt) * 16 + col] = s2;
            __syncthreads();
            const float tot = (ssbuf[(mtile * 4 + 0) * 16 + col] + ssbuf[(mtile * 4 + 1) * 16 + col]) + (ssbuf[(mtile * 4 + 2) * 16 + col] + ssbuf[(mtile * 4 + 3) * 16 + col]);
            if (!kv) rr = rsqrtf(tot * (1.f / 64.f) + EPS);
        }
        {
            float4 gn = {1.f, 1.f, 1.f, 1.f};
            if (!kv) gn = *(const float4*)(p.k_norm_cmp + l * 64 + 16 * nt + 4 * kq);
            uint2 o; o.x = pk2(acc2[0] * rr * gn.x, acc2[1] * rr * gn.y); o.y = pk2(acc2[2] * rr * gn.z, acc2[3] * rr * gn.w);
            if (c >= 255) { o.x = 0u; o.y = 0u; }
            const int imgc = kv ? ((nt >> 1) * 2048 + (c & 63) * 32 + 16 * (nt & 1) + 4 * kq) : ((2 * nt + (kq >> 1)) * 512 + (c & 63) * 8 + 4 * (kq & 1));
            *(uint2*)((kv ? p.Vc : p.Kc) + (size_t)(b * 2 + g) * 256 * 64 + (size_t)(c >> 6) * 4096 + imgc) = o;
        }
        __syncthreads();
    }
}

constexpr int NPHASES = 1 + 6 + 5;
#ifndef PH_MASK
#define PH_MASK 0xFF
#endif
DEV void run_phase(int ph, int bid, int nb, char* lds, int pass = 0) {
    asm volatile("" : "+s"(bid), "+s"(nb));
    unsigned long long kp = (unsigned long long)__builtin_amdgcn_kernarg_segment_ptr();
    asm volatile("" : "+s"(kp));
    CP p = *(const __attribute__((address_space(4))) Params*)kp;
    if (ph == 0) { if (PH_MASK & 1) phase0_prep(p, bid, nb, lds); return; }
    const int l = (ph - 1) / 6, s = (ph - 1) % 6;
    if (s == 0) { if (PH_MASK & 2) { if (NAIVE_GEMM) phase_gemm_naive<0>(p.H, p.wt_in + (size_t)l * DP * DM, DP, p.P, nullptr, nullptr, bid, nb); else phase_gemm_in(p, l, bid, nb, lds); } }
    else if (s == 1) { if (PH_MASK & 4) { if (NAIVE_P2) phase2_post_naive(p, l, bid, nb, lds); else phase2_post_fast(p, l, bid, nb, lds); } }
    else if (s == 2) {
        if (PH_MASK & 8) { if (NAIVE_DSA) phase3_dsa_naive(p, l, bid, nb, lds); else phase3_dsa_fast(p, l, bid, nb, lds); }
#ifndef SPLIT_ATTN
        __syncthreads();
        if (PH_MASK & 16) { if (NAIVE_NSA) phase3_nsa_naive(p, l, bid, nb, lds); else phase3_nsa_fast(p, l, bid, nb, lds, pass); }
#endif
    }
    else if (s == 3) {
#ifdef SPLIT_ATTN
        if (PH_MASK & 16) { if (NAIVE_NSA) phase3_nsa_naive(p, l, bid, nb, lds); else phase3_nsa_fast(p, l, bid, nb, lds, pass); }
#endif
    }
    else if (s == 4) { if (PH_MASK & 32) { if (NAIVE_GEMM) phase_gemm_naive<1>(p.H, p.wt_out + (size_t)l * DM * DM, DM, nullptr, l == 0 ? p.x : p.out, p.out, bid, nb); else phase_gemm_out(p, l, bid, nb, lds, pass ? p.out2 : p.out); } }
    else { if (PH_MASK & 64) phase_norm_hb(p, 1, bid, nb); }
}


DEV unsigned long long chk_range(const void* base, size_t bytes, int bid, int nb) {
    const uint4* q = (const uint4*)base; const size_t n = bytes / 16; unsigned long long acc = 0ull;
    for (size_t i = (size_t)bid * NTHREADS + tidx(); i < n; i += (size_t)nb * NTHREADS) { const uint4 v = q[i]; acc += (unsigned long long)v.x + ((unsigned long long)v.y << 7) + ((unsigned long long)v.z << 13) + ((unsigned long long)v.w << 19); }
    return acc;
}
DEV void checksum_phase(int ph, int pass, int bid, int nb, float* outp) {
    unsigned long long kp = (unsigned long long)__builtin_amdgcn_kernarg_segment_ptr();
    asm volatile("" : "+s"(kp));
    CP p = *(const __attribute__((address_space(4))) Params*)kp;
    unsigned long long a = 0ull;
    if (ph == 0) {
        a += chk_range(p.H, (size_t)NTOK * DM * 2, bid, nb); a += chk_range(p.wt_in, (size_t)2 * DP * DM * 2, bid, nb); a += chk_range(p.wt_out, (size_t)2 * DM * DM * 2, bid, nb);
        a += chk_range(p.wt_kvup, (size_t)2 * 256 * 128 * 2, bid, nb); a += chk_range(p.wt_c1k, (size_t)2 * 64 * 2048 * 2, bid, nb); a += chk_range(p.wt_c1v, (size_t)2 * 64 * 2048 * 2, bid, nb);
        a += chk_range(p.wt_c2k, (size_t)2 * 64 * 64 * 2, bid, nb); a += chk_range(p.wt_c2v, (size_t)2 * 64 * 64 * 2, bid, nb);
        a += chk_range(p.cbias_k, 2 * 64 * 4, bid, nb); a += chk_range(p.cbias_v, 2 * 64 * 4, bid, nb); a += chk_range(p.biasd, 16 * 1024 * 4, bid, nb);
    } else {
        const int s = (ph - 1) % 6;
        if (s == 0) a += chk_range(p.P, (size_t)NTOK * DP * 2, bid, nb);
        else if (s == 1) { a += chk_range(p.P, (size_t)NTOK * DP * 2, bid, nb); a += chk_range(p.Ka, (size_t)NTOK * 128 * 2, bid, nb); a += chk_range(p.Va, (size_t)NTOK * 128 * 2, bid, nb);
                           a += chk_range(p.Kc, (size_t)NBATCH * 2 * 256 * 64 * 2, bid, nb); a += chk_range(p.Vc, (size_t)NBATCH * 2 * 256 * 64 * 2, bid, nb); }
        else if (s == 2 || s == 3 || s == 5) a += chk_range(p.H, (size_t)NTOK * DM * 2, bid, nb);
        else a += chk_range(outp, (size_t)NTOK * DM * 4, bid, nb);
    }
#pragma unroll
    for (int o = 1; o < 64; o <<= 1) a += __shfl_xor(a, o);
    if ((tidx() & 63) == 0) atomicAdd(p.chk + pass * 16 + ph, a);
}

#define XB_TMO      128
#define XB_XCNT(j)  (256  + 64 * (j))
#define XB_XSUB(j)  (1280 + 64 * (j))
#define XB_XGEN(j)  (2304 + 64 * (j))
#define XB_TOP      3328
#define XB_TOPGEN   3392
#define XCD_BAR_WORDS 3456
#define XB_SPIN_CAP (1u << 20)
DEV unsigned xb_ld(unsigned* p)              { return __hip_atomic_load(p, __ATOMIC_RELAXED, __HIP_MEMORY_SCOPE_AGENT); }
DEV unsigned xb_add(unsigned* p, unsigned v) { return __hip_atomic_fetch_add(p, v, __ATOMIC_RELAXED, __HIP_MEMORY_SCOPE_AGENT); }
DEV unsigned xb_xcc_id() { return (unsigned)__builtin_amdgcn_s_getreg((3 << 11) | 20) & 0xFu; }
#define XB_SPIN(cond, bar) do { unsigned _sp = 0; while (cond) { __builtin_amdgcn_s_sleep(1); \
    if ((++_sp & 255u) == 0u) { if (xb_ld(&(bar)[XB_TMO])) break; if (_sp > XB_SPIN_CAP) { atomicAdd(&(bar)[XB_TMO], 1u); break; } } } } while (0)
struct XcdBarrier { unsigned* bar; unsigned x; volatile __attribute__((address_space(3))) unsigned* st; };
DEV XcdBarrier xcd_barrier_post(unsigned* bar, volatile __attribute__((address_space(3))) unsigned* st) {
    XcdBarrier b; b.bar = bar; b.x = xb_xcc_id(); b.st = st;
    if (tidx() == 0) { const unsigned rk = xb_add(&bar[XB_XCNT(b.x)], 1u); st[2] = rk; st[3] = b.x; }
    return b;
}
DEV void xcd_barrier_complete(unsigned* bar, unsigned x, unsigned& nloc, unsigned& nx) {
    const unsigned G = gridDim.x * gridDim.y * gridDim.z;
    unsigned sum, cnt, mine, sp = 0u;
    for (;;) {
        sum = 0u; cnt = 0u; mine = 0u;
#pragma unroll
        for (unsigned j = 0; j < 16; ++j) { const unsigned c = xb_ld(&bar[XB_XCNT(j)]); sum += c; cnt += (c > 0u) ? 1u : 0u; mine = (j == x) ? c : mine; }
        if (sum == G) break;
        __builtin_amdgcn_s_sleep(1);
        if ((++sp & 255u) == 0u) { if (xb_ld(&bar[XB_TMO])) break; if (sp > XB_SPIN_CAP) { atomicAdd(&bar[XB_TMO], 1u); break; } }
    }
    nloc = mine > 0u ? mine : 1u; nx = cnt > 0u ? cnt : 1u;
}
DEV void xcd_barrier(const XcdBarrier& b) {
    asm volatile("s_waitcnt vmcnt(0)" ::: "memory");
    __syncthreads();
    if (tidx() == 0) {
        unsigned* bar = b.bar;
        __builtin_amdgcn_s_waitcnt(0);
        unsigned nloc = b.st[0], nx = b.st[1];
        if (nloc == 0u) { xcd_barrier_complete(bar, b.x, nloc, nx); b.st[0] = nloc; b.st[1] = nx; }
        const unsigned old = xb_add(&bar[XB_XSUB(b.x)], 1u);
        const unsigned gen = old / nloc;
        if (old + 1u == (gen + 1u) * nloc) {
            __builtin_amdgcn_fence(__ATOMIC_RELEASE, "agent");
            asm volatile("s_waitcnt vmcnt(0)" ::: "memory");
            const unsigned og = xb_add(&bar[XB_TOP], 1u);
            const unsigned tg = og / nx;
            if (og + 1u == (tg + 1u) * nx) xb_add(&bar[XB_TOPGEN], 1u);
            else XB_SPIN(xb_ld(&bar[XB_TOPGEN]) == tg, bar);
            __builtin_amdgcn_fence(__ATOMIC_ACQUIRE, "agent");
            xb_add(&bar[XB_XGEN(b.x)], 1u);
            asm volatile("s_waitcnt vmcnt(0)" ::: "memory");
        } else {
            XB_SPIN(xb_ld(&bar[XB_XGEN(b.x)]) == gen, bar);
            __builtin_amdgcn_fence(__ATOMIC_ACQUIRE, "agent");
            asm volatile("s_waitcnt vmcnt(0)" ::: "memory");
        }
    }
    __syncthreads();
}


DEV void xcd_barrier_light(const XcdBarrier& b) {
    __syncthreads();
    if (tidx() == 0) {
        unsigned* bar = b.bar;
        const unsigned nloc = b.st[0], nx = b.st[1];
        const unsigned old = xb_add(&bar[XB_XSUB(b.x)], 1u);
        const unsigned gen = old / nloc;
        if (old + 1u == (gen + 1u) * nloc) {
            const unsigned og = xb_add(&bar[XB_TOP], 1u);
            const unsigned tg = og / nx;
            if (og + 1u == (tg + 1u) * nx) xb_add(&bar[XB_TOPGEN], 1u);
            else XB_SPIN(xb_ld(&bar[XB_TOPGEN]) == tg, bar);
            xb_add(&bar[XB_XGEN(b.x)], 1u);
        } else {
            XB_SPIN(xb_ld(&bar[XB_XGEN(b.x)]) == gen, bar);
        }
        asm volatile("s_waitcnt vmcnt(0)" ::: "memory");
    }
    __syncthreads();
}

DEV void grid_barrier(cg::grid_group& grid) {
    asm volatile("s_waitcnt vmcnt(0) lgkmcnt(0)" ::: "memory");
    __syncthreads();
    if (tidx() < 64) { __builtin_amdgcn_fence(__ATOMIC_RELEASE, "agent"); asm volatile("s_waitcnt vmcnt(0)" ::: "memory"); }
    __syncthreads();
    grid.sync();
    __builtin_amdgcn_fence(__ATOMIC_ACQUIRE, "agent");
    asm volatile("s_waitcnt vmcnt(0)" ::: "memory");
    __syncthreads();
}

DEV int vbid_for(int ph, int bid, int rank, int x, const XcdBarrier& b, int nb) {
    if (ph == 0) return bid;
    const int s = (ph - 1) % 6;
    if (s != 2 && s != 3) return bid;
    const unsigned nloc = (unsigned)__builtin_amdgcn_readfirstlane((int)b.st[0]), nx = (unsigned)__builtin_amdgcn_readfirstlane((int)b.st[1]);
    const bool balanced = (nx == 8u) && (nloc * 8u == (unsigned)nb) && ((nb & 7) == 0);
    return balanced ? rank * 8 + x : bid;
}

__global__ void __launch_bounds__(NTHREADS) k_fwd(Params p, int ph_lo, int ph_hi) {
    extern __shared__ __attribute__((aligned(16))) char lds[];
    cg::grid_group grid = cg::this_grid();
    volatile __attribute__((address_space(3))) unsigned* st = (volatile __attribute__((address_space(3))) unsigned*)((__attribute__((address_space(3))) char*)lds + LDS_BYTES - 16);
    if (tidx() == 0) { st[0] = 0u; st[1] = 0u; }
    __syncthreads();
    const __attribute__((address_space(4))) Params* barp = (const __attribute__((address_space(4))) Params*)(unsigned long long)__builtin_amdgcn_kernarg_segment_ptr();
    unsigned* barw = barp->ctrl;
    grid.sync();
    XcdBarrier xb = xcd_barrier_post(barw, st);
    __syncthreads();
    const int vb_rank = __builtin_amdgcn_readfirstlane((int)st[2]), vb_x = __builtin_amdgcn_readfirstlane((int)st[3]);
#ifdef SELFCHECK
    for (int pass = 0; pass < 2; ++pass) {
        for (int ph = ph_lo; ph < ph_hi; ++ph) {
            run_phase(ph, blockIdx.x, gridDim.x, lds, pass);
            xcd_barrier(xb); xcd_barrier_light(xb);
            checksum_phase(ph, pass, blockIdx.x, gridDim.x, pass ? barp->out2 : barp->out);
            xcd_barrier(xb); xcd_barrier_light(xb);
        }
    }
    if (blockIdx.x == 0 && tidx() == 0) {
        int f = -1;
        for (int ph = NPHASES - 1; ph >= 0; --ph) if (__hip_atomic_load(barp->chk + ph, __ATOMIC_RELAXED, __HIP_MEMORY_SCOPE_AGENT) != __hip_atomic_load(barp->chk + 16 + ph, __ATOMIC_RELAXED, __HIP_MEMORY_SCOPE_AGENT)) f = ph;
        if (f < 0) { for (int k = 3; k >= 0; --k) if (__hip_atomic_load(barp->chk + 32 + k, __ATOMIC_RELAXED, __HIP_MEMORY_SCOPE_AGENT) != __hip_atomic_load(barp->chk + 40 + k, __ATOMIC_RELAXED, __HIP_MEMORY_SCOPE_AGENT)) f = 12 + k; }
        else { int g2 = -1; for (int k = 3; k >= 0; --k) if (__hip_atomic_load(barp->chk + 32 + k, __ATOMIC_RELAXED, __HIP_MEMORY_SCOPE_AGENT) != __hip_atomic_load(barp->chk + 40 + k, __ATOMIC_RELAXED, __HIP_MEMORY_SCOPE_AGENT)) g2 = k; if (g2 >= 0) f = 12 + g2; }
        if (f >= 0) barp->out[0] = 20.f * (float)(f + 1);
    }
#else
    for (int ph = ph_lo; ph < ph_hi; ++ph) {
#ifndef SPLIT_ATTN
        if (ph > 0 && ((ph - 1) % 6 == 3 || (ph - 1) % 6 == 5)) continue;
#endif
        run_phase(ph, vbid_for(ph, (int)blockIdx.x, vb_rank, vb_x, xb, (int)gridDim.x), gridDim.x, lds);
#ifdef REP_PH
        if (ph == REP_PH) { xcd_barrier(xb); xcd_barrier_light(xb); run_phase(ph, blockIdx.x, gridDim.x, lds); }
#endif
#ifdef REP_BAR
        if (ph == 3) { for (int q = 0; q < REP_BAR; ++q) { xcd_barrier(xb); xcd_barrier_light(xb); } }
#endif
#ifdef REP_S
        if (ph > 0 && (ph - 1) % 6 == REP_S) { xcd_barrier(xb); xcd_barrier_light(xb); run_phase(ph, blockIdx.x, gridDim.x, lds); }
#endif
        if (ph + 1 < ph_hi) { xcd_barrier(xb); xcd_barrier_light(xb); }
    }
#endif
}

extern "C" void kernel_launch(void* const* d_in, const int* in_sizes, int n_in, void* d_out, int out_size, void* d_ws, size_t ws_size, hipStream_t stream) {
    static int grid = 0;
    if (grid == 0) {
        int dev = 0, cus = 0, per_cu = 0;
        hipGetDevice(&dev);
        hipDeviceGetAttribute(&cus, hipDeviceAttributeMultiprocessorCount, dev);
        hipFuncSetAttribute((const void*)k_fwd, hipFuncAttributeMaxDynamicSharedMemorySize, LDS_BYTES);
        hipOccupancyMaxActiveBlocksPerMultiprocessor(&per_cu, (const void*)k_fwd, NTHREADS, LDS_BYTES);
        if (per_cu < 1) { fprintf(stderr, "occupancy query: %d blocks per CU\n", per_cu); per_cu = 1; }
        grid = cus * per_cu;
    }
    Params p{};
    const float** ins = (const float**)&p;
    for (int i = 0; i < 20; ++i) ins[i] = (const float*)d_in[i];
    p.out = (float*)d_out;
    char* w = (char*)d_ws; size_t off = 0;
    auto take = [&](size_t bytes) { char* r = w + off; off += (bytes + 255) & ~(size_t)255; return r; };
    p.ctrl = (unsigned*)take(XCD_BAR_WORDS * 4 + 1024);
    p.chk = (unsigned long long*)(p.ctrl + XCD_BAR_WORDS);
    p.wt_in = (bf16_t*)take((size_t)2 * DP * DM * 2);
    p.wt_out = (bf16_t*)take((size_t)2 * DM * DM * 2);
    p.wt_kvup = (bf16_t*)take((size_t)2 * 256 * 128 * 2);
    p.wt_c1k = (bf16_t*)take((size_t)2 * 64 * 2048 * 2);
    p.wt_c1v = (bf16_t*)take((size_t)2 * 64 * 2048 * 2);
    p.wt_c2k = (bf16_t*)take((size_t)2 * 64 * 64 * 2);
    p.wt_c2v = (bf16_t*)take((size_t)2 * 64 * 64 * 2);
    p.cbias_k = (float*)take(2 * 64 * 4);
    p.cbias_v = (float*)take(2 * 64 * 4);
    p.biasd = (float*)take(16 * 1024 * 4);
    p.H = (bf16_t*)take((size_t)NTOK * DM * 2);
    p.P = (bf16_t*)take((size_t)NTOK * DP * 2);
    p.Ka = (bf16_t*)take((size_t)NTOK * 128 * 2);
    p.Va = (bf16_t*)take((size_t)NTOK * 128 * 2);
    p.Ki = (bf16_t*)take((size_t)NTOK * 64 * 2);
    p.Ks = (bf16_t*)take((size_t)NTOK * 128 * 2); p.Vs = (bf16_t*)take((size_t)NTOK * 128 * 2); p.Kw = (bf16_t*)take((size_t)NTOK * 128 * 2); p.Vw = (bf16_t*)take((size_t)NTOK * 128 * 2);
    p.Kc = (bf16_t*)take((size_t)NBATCH * 2 * 256 * 64 * 2);
    p.Vc = (bf16_t*)take((size_t)NBATCH * 2 * 256 * 64 * 2);
#ifdef SELFCHECK
    p.out2 = (float*)take((size_t)NTOK * DM * 4);
#endif
    p.x1b = (bf16_t*)take((size_t)NTOK * DM * 2);
    p.ssq = (float*)take((size_t)NTOK * 16 * 4);
    if (off > ws_size) { fprintf(stderr, "workspace too small: need %zu have %zu\n", off, ws_size); return; }
    hipMemsetAsync(p.ctrl, 0, XCD_BAR_WORDS * 4 + 1024, stream);
#if MEGA
    int lo = 0, hi = NPHASES;
    void* args[] = {&p, &lo, &hi};
    hipError_t e = hipLaunchCooperativeKernel((const void*)k_fwd, dim3(grid), dim3(NTHREADS), args, LDS_BYTES, stream);
    if (e != hipSuccess) fprintf(stderr, "cooperative launch failed: %s (grid %d)\n", hipGetErrorString(e), grid);
#else
    for (int ph = 0; ph < NPHASES; ++ph) hipLaunchKernelGGL(k_fwd, dim3(grid), dim3(NTHREADS), LDS_BYTES, stream, p, ph, ph + 1);
#endif
}
```

```cpp
#include <hip/hip_runtime.h>
#include <hip/hip_cooperative_groups.h>
#include <stdint.h>
#include <stdio.h>
namespace cg = cooperative_groups;

#ifndef MEGA
#define MEGA 1
#endif
#ifndef NAIVE_NSA
#define NAIVE_NSA 0
#endif
#ifndef NAIVE_DSA
#define NAIVE_DSA 0
#endif
#ifndef NAIVE_P2
#define NAIVE_P2 0
#endif
#ifndef NAIVE_GEMM
#define NAIVE_GEMM 0
#endif

typedef unsigned short bf16_t;
typedef unsigned long long u64;
#define DEV __device__ __forceinline__

constexpr int NSAQ_WORD = 3456 + 128;
constexpr int NBATCH = 8, SEQ = 4096, DM = 1024, NTOK = NBATCH * SEQ, DIN = 3552, DP = 3584, PP = DP + 64;
constexpr int NTHREADS = 512, NWAVES = 8;
constexpr int C_QA = 0, C_QI = 512, C_ZA = 1024, C_QB = 1536, C_ZB = 2048, C_CKV = 2560, C_KI = 2688, C_WI = 2752, C_GB = 2760,
              C_KC = 2816, C_VC = 2944, C_KS = 3072, C_VS = 3200, C_KW = 3328, C_VW = 3456;
constexpr float EPS = 1e-6f;
constexpr int LDS_BYTES = 152 * 1024;

struct Params;
typedef const __attribute__((address_space(4))) Params& CP;
struct Params {
    const float *x, *rel_bias, *norm_g, *w_in, *b_gate_b, *kv_norm_a, *w_kv_up_a, *q_norm_a, *k_norm_a, *q_norm_b, *k_norm_cmp, *k_norm_slc,
        *k_norm_win, *cmp_pos_k, *cmp_pos_v, *w_cmp_k1, *w_cmp_k2, *w_cmp_v1, *w_cmp_v2, *w_out;
    float* out;
    bf16_t *wt_in, *wt_out, *wt_kvup, *wt_c1k, *wt_c1v, *wt_c2k, *wt_c2v;
    float *cbias_k, *cbias_v, *biasd;
    bf16_t *H, *P, *Ka, *Va, *Kc, *Vc;
    unsigned* ctrl;
    float* out2; unsigned long long* chk;
    bf16_t* x1b;
    bf16_t* xb;
    float* ssq;
    bf16_t *Ki, *Ks, *Vs, *Kw, *Vw;
};

typedef float f32x2_t __attribute__((ext_vector_type(2)));
typedef __bf16 bf16x2_t __attribute__((ext_vector_type(2)));
DEV unsigned cvt_pk_rne(float lo, float hi) { f32x2_t v = {lo, hi}; bf16x2_t b = __builtin_convertvector(v, bf16x2_t); return __builtin_bit_cast(unsigned, b); }
DEV int tidx() { int t = (int)__builtin_amdgcn_workitem_id_x(); asm volatile("" : "+v"(t)); return t; }
DEV float bf2f(bf16_t v) { return __uint_as_float(((unsigned)v) << 16); }
DEV bf16_t f2bf(float f) { unsigned u = __float_as_uint(f); u += 0x7FFFu + ((u >> 16) & 1u); return (bf16_t)(u >> 16); }
DEV unsigned pk2(float lo, float hi) { return cvt_pk_rne(lo, hi); }
DEV void unpack8g(const uint4 v, float (&x)[8]) {
    x[0] = __uint_as_float(v.x << 16); x[1] = __uint_as_float(v.x & 0xFFFF0000u); x[2] = __uint_as_float(v.y << 16); x[3] = __uint_as_float(v.y & 0xFFFF0000u);
    x[4] = __uint_as_float(v.z << 16); x[5] = __uint_as_float(v.z & 0xFFFF0000u); x[6] = __uint_as_float(v.w << 16); x[7] = __uint_as_float(v.w & 0xFFFF0000u);
}
DEV float wave_sum(float v) {
#pragma unroll
    for (int o = 1; o < 64; o <<= 1) v += __shfl_xor(v, o);
    return v;
}
DEV float wave_max(float v) {
#pragma unroll
    for (int o = 1; o < 64; o <<= 1) v = fmaxf(v, __shfl_xor(v, o));
    return v;
}
DEV int wave_sum_i(int v) {
#pragma unroll
    for (int o = 1; o < 64; o <<= 1) v += __shfl_xor(v, o);
    return v;
}
DEV unsigned f2key(float f) { unsigned u = __float_as_uint(f); return (u & 0x80000000u) ? ~u : (u | 0x80000000u); }
DEV float silu(float z) { return z * __builtin_amdgcn_rcpf(1.f + __expf(-z)); }
DEV float sigmoidf_(float z) { return __builtin_amdgcn_rcpf(1.f + __expf(-z)); }
DEV float gelu_tanh(float x) { const float y = 0.7978845608028654f * (x + 0.044715f * x * x * x); const float t = 1.f - 2.f * __builtin_amdgcn_rcpf(__expf(2.f * y) + 1.f); return 0.5f * x * (1.f + t); }
DEV int t5_bucket(int d) {
    if (d < 16) return d < 0 ? 0 : d;
    int b = 16;
    b += (d >= 21); b += (d >= 27); b += (d >= 35); b += (d >= 46); b += (d >= 59); b += (d >= 77); b += (d >= 99); b += (d >= 128);
    b += (d >= 166); b += (d >= 216); b += (d >= 280); b += (d >= 363); b += (d >= 470); b += (d >= 609); b += (d >= 790);
    return b;
}
DEV int src_col(int n) {
    if (n < 512) return n;
    if (n < 1024) return 640 + (n - 512);
    if (n < 1536) return 1224 + (n - 1024);
    if (n < 2048) return 1736 + (n - 1536);
    if (n < 2560) return 3040 + (n - 2048);
    if (n < 2688) return 512 + (n - 2560);
    if (n < 2752) return 1152 + (n - 2688);
    if (n < 2760) return 1216 + (n - 2752);
    if (n < 2784) return 3016 + (n - 2760);
    if (n < 2816) return -1;
    return 2248 + (n - 2816);
}
DEV float dot64(const bf16_t* __restrict__ row, const float* q) {
    float acc = 0.f;
#pragma unroll
    for (int c = 0; c < 8; ++c) {
        const uint4 v = *(const uint4*)(row + c * 8);
        const unsigned w[4] = {v.x, v.y, v.z, v.w};
#pragma unroll
        for (int j = 0; j < 4; ++j) { acc = fmaf(__uint_as_float(w[j] << 16), q[c * 8 + 2 * j], acc); acc = fmaf(__uint_as_float(w[j] & 0xFFFF0000u), q[c * 8 + 2 * j + 1], acc); }
    }
    return acc;
}

struct TileDesc { const float* src; int Nsrc; bf16_t* dst; int K, k0, n0; bool colmap; const float* kscale; };
DEV void transpose_pair(const TileDesc& A, const TileDesc& B, bool hasB, float* tile  ) {
    const int tid = tidx();
    {
        const int nn = tid & 63, kk0 = tid >> 6;
        int scA = A.n0 + nn; if (A.colmap) scA = src_col(scA);
        int scB = B.n0 + nn; if (B.colmap) scB = src_col(scB);
        const float* spA = A.src + (size_t)(A.k0 + kk0) * A.Nsrc + max(scA, 0);
        const float* spB = B.src + (size_t)(B.k0 + kk0) * B.Nsrc + max(scB, 0);
        float va[8], vb[8];
#pragma unroll
        for (int i = 0; i < 8; ++i) va[i] = spA[(size_t)(8 * i) * A.Nsrc];
#pragma unroll
        for (int i = 0; i < 8; ++i) vb[i] = spB[(size_t)(8 * i) * B.Nsrc];
#pragma unroll
        for (int i = 0; i < 8; ++i) tile[(kk0 + 8 * i) * 65 + nn] = (scA >= 0) ? (A.kscale ? va[i] * A.kscale[A.k0 + kk0 + 8 * i] : va[i]) : 0.f;
#pragma unroll
        for (int i = 0; i < 8; ++i) tile[64 * 65 + (kk0 + 8 * i) * 65 + nn] = (scB >= 0) ? (B.kscale ? vb[i] * B.kscale[B.k0 + kk0 + 8 * i] : vb[i]) : 0.f;
    }
    __syncthreads();
    {
        const int nn = tid >> 3, kg = tid & 7;
#pragma unroll
        for (int h = 0; h < 2; ++h) {
            const float* tl = tile + h * 64 * 65;
            uint4 o;
            o.x = pk2(tl[(8 * kg + 0) * 65 + nn], tl[(8 * kg + 1) * 65 + nn]); o.y = pk2(tl[(8 * kg + 2) * 65 + nn], tl[(8 * kg + 3) * 65 + nn]);
            o.z = pk2(tl[(8 * kg + 4) * 65 + nn], tl[(8 * kg + 5) * 65 + nn]); o.w = pk2(tl[(8 * kg + 6) * 65 + nn], tl[(8 * kg + 7) * 65 + nn]);
            const TileDesc& D = h ? B : A;
            if (h == 0 || hasB) *(uint4*)(D.dst + (size_t)(D.n0 + nn) * D.K + D.k0 + 8 * kg) = o;
        }
    }
    __syncthreads();
}
DEV void rms_row_to_bf16(const float* __restrict__ xrow, const float* __restrict__ g, bf16_t* __restrict__ orow, int lane) {
    float4 v[4]; float s = 0.f;
#pragma unroll
    for (int j = 0; j < 4; ++j) { v[j] = ((const float4*)xrow)[lane + 64 * j]; s += v[j].x * v[j].x + v[j].y * v[j].y + v[j].z * v[j].z + v[j].w * v[j].w; }
    const float r = rsqrtf(wave_sum(s) * (1.f / DM) + EPS);
#pragma unroll
    for (int j = 0; j < 4; ++j) {
        const float4 gg = ((const float4*)g)[lane + 64 * j];
        uint2 o; o.x = pk2(v[j].x * r * gg.x, v[j].y * r * gg.y); o.y = pk2(v[j].z * r * gg.z, v[j].w * r * gg.w);
        ((uint2*)orow)[lane + 64 * j] = o;
    }
}
DEV void rms_rowb_to_bf16(const bf16_t* __restrict__ xrow, const float* __restrict__ g, bf16_t* __restrict__ orow, int lane) {
    float v[2][8]; float s = 0.f;
#pragma unroll
    for (int j = 0; j < 2; ++j) { unpack8g(((const uint4*)xrow)[lane + 64 * j], v[j]);
#pragma unroll
        for (int e = 0; e < 8; ++e) s = fmaf(v[j][e], v[j][e], s); }
    const float r = rsqrtf(wave_sum(s) * (1.f / DM) + EPS);
#pragma unroll
    for (int j = 0; j < 2; ++j) {
        const float4 g0 = ((const float4*)g)[2 * (lane + 64 * j)], g1 = ((const float4*)g)[2 * (lane + 64 * j) + 1];
        uint4 o; o.x = pk2(v[j][0] * r * g0.x, v[j][1] * r * g0.y); o.y = pk2(v[j][2] * r * g0.z, v[j][3] * r * g0.w); o.z = pk2(v[j][4] * r * g1.x, v[j][5] * r * g1.y); o.w = pk2(v[j][6] * r * g1.z, v[j][7] * r * g1.w);
        ((uint4*)orow)[lane + 64 * j] = o;
    }
}
DEV void phase_norm_hb(CP p, int layer, int bid, int nb) {
    const int wid = tidx() >> 6, lane = tidx() & 63;
    for (int row = bid * NWAVES + wid; row < NTOK; row += nb * NWAVES) rms_rowb_to_bf16(p.x1b + (size_t)row * DM, p.norm_g + layer * DM, p.H + (size_t)row * DM, lane);
}
DEV float wave_sum_fast(float v) {
    v += __int_as_float(__builtin_amdgcn_update_dpp(0, __float_as_int(v), 0xB1, 0xF, 0xF, true));
    v += __int_as_float(__builtin_amdgcn_update_dpp(0, __float_as_int(v), 0x4E, 0xF, 0xF, true));
    v += __int_as_float(__builtin_amdgcn_update_dpp(0, __float_as_int(v), 0x141, 0xF, 0xF, true));
    v += __int_as_float(__builtin_amdgcn_update_dpp(0, __float_as_int(v), 0x140, 0xF, 0xF, true));
    const int iv = __float_as_int(v);
    return (__int_as_float(__builtin_amdgcn_readlane(iv, 0)) + __int_as_float(__builtin_amdgcn_readlane(iv, 16))) + (__int_as_float(__builtin_amdgcn_readlane(iv, 32)) + __int_as_float(__builtin_amdgcn_readlane(iv, 48)));
}
DEV void phase_norm_h(CP p, const float* __restrict__ src, int layer, int bid, int nb) {
    const int wid = tidx() >> 6, lane = tidx() & 63;
    const int stride = nb * NWAVES;
    for (int row = bid * NWAVES + wid; row < NTOK; row += 4 * stride) {
        float4 v[4][4];
#pragma unroll
        for (int q = 0; q < 4; ++q) { const float* xr = src + (size_t)min(row + q * stride, NTOK - 1) * DM;
#pragma unroll
            for (int j = 0; j < 4; ++j) v[q][j] = ((const float4*)xr)[lane + 64 * j]; }
#pragma unroll
        for (int q = 0; q < 4; ++q) {
            float s = 0.f;
#pragma unroll
            for (int j = 0; j < 4; ++j) s += v[q][j].x * v[q][j].x + v[q][j].y * v[q][j].y + v[q][j].z * v[q][j].z + v[q][j].w * v[q][j].w;
            const float tot = wave_sum_fast(s);
            if (row + q * stride < NTOK) {
                bf16_t* orow = p.xb + (size_t)(row + q * stride) * DM;
#pragma unroll
                for (int j = 0; j < 4; ++j) { uint2 o; o.x = pk2(v[q][j].x, v[q][j].y); o.y = pk2(v[q][j].z, v[q][j].w); ((uint2*)orow)[lane + 64 * j] = o; }
                if (lane < 16) p.ssq[(size_t)(row + q * stride) * 16 + lane] = lane == 0 ? tot : 0.f;
            }
        }
    }
}
DEV void phase0_prep(CP p, int bid, int nb, char* lds) {
    float* tile = (float*)lds;
    const int tid = tidx();
    constexpr int T_IN = (DP / 64) * (DM / 64), T_OUT = 16 * 16, T_KV = 2 * 4, T_C1 = 32, T_C2 = 1, T_L = T_IN + T_OUT + T_KV + 2 * T_C1 + 2 * T_C2;
    auto desc = [&](int it) -> TileDesc {
        const int l = it / T_L; int r = it % T_L;
        if (r < T_IN) { const int nt = r / (DM / 64), kt = r % (DM / 64); return TileDesc{p.w_in + (size_t)l * DM * DIN, DIN, p.wt_in + (size_t)l * DP * DM, DM, kt * 64, nt * 64, true, p.norm_g + l * DM}; } r -= T_IN;
        if (r < T_OUT) { const int nt = r / 16, kt = r % 16; return TileDesc{p.w_out + (size_t)l * DM * DM, DM, p.wt_out + (size_t)l * DM * DM, DM, kt * 64, nt * 64, false, nullptr}; } r -= T_OUT;
        if (r < T_KV) { const int nt = r / 2, kt = r % 2; return TileDesc{p.w_kv_up_a + (size_t)l * 128 * 256, 256, p.wt_kvup + (size_t)l * 256 * 128, 128, kt * 64, nt * 64, false, nullptr}; } r -= T_KV;
        if (r < T_C1) return TileDesc{p.w_cmp_k1 + (size_t)l * 2048 * 64, 64, p.wt_c1k + (size_t)l * 64 * 2048, 2048, r * 64, 0, false, nullptr}; r -= T_C1;
        if (r < T_C1) return TileDesc{p.w_cmp_v1 + (size_t)l * 2048 * 64, 64, p.wt_c1v + (size_t)l * 64 * 2048, 2048, r * 64, 0, false, nullptr}; r -= T_C1;
        if (r < T_C2) return TileDesc{p.w_cmp_k2 + (size_t)l * 64 * 64, 64, p.wt_c2k + (size_t)l * 64 * 64, 64, 0, 0, false, nullptr};
        return TileDesc{p.w_cmp_v2 + (size_t)l * 64 * 64, 64, p.wt_c2v + (size_t)l * 64 * 64, 64, 0, 0, false, nullptr};
    };
    for (int it = bid; it < 2 * T_L; it += 2 * nb) {
        const bool hasB = it + nb < 2 * T_L;
        const TileDesc A = desc(it), B = desc(hasB ? it + nb : it);
        transpose_pair(A, B, hasB, tile);
    }
    for (int it = bid; it < 32; it += nb) {
        const int l = it >> 4, kv = (it >> 3) & 1, n0 = (it & 7) * 8;
        const float* pos = (kv ? p.cmp_pos_v : p.cmp_pos_k) + (size_t)l * 2048;
        const float* w1 = (kv ? p.w_cmp_v1 : p.w_cmp_k1) + (size_t)l * 2048 * 64;
        const int n = tid & 7, part = tid >> 3;
        float wv[32], pv[32];
#pragma unroll
        for (int i = 0; i < 32; ++i) { wv[i] = w1[(size_t)(part * 32 + i) * 64 + n0 + n]; pv[i] = pos[part * 32 + i]; }
        float acc = 0.f;
#pragma unroll
        for (int i = 0; i < 32; ++i) acc = fmaf(pv[i], wv[i], acc);
        tile[part * 8 + n] = acc;
        __syncthreads();
        if (tid < 8) { float s = 0.f; for (int q = 0; q < 64; ++q) s += tile[q * 8 + tid]; (kv ? p.cbias_v : p.cbias_k)[l * 64 + n0 + tid] = s; }
        __syncthreads();
    }
    for (int e = bid * NTHREADS + tid; e < 16 * 1024; e += nb * NTHREADS) { const int h = e >> 10, d = e & 1023; p.biasd[e] = p.rel_bias[t5_bucket(d) * 16 + h]; }
    phase_norm_h(p, p.x, 0, bid, nb);
}

template <int MODE  >
DEV void phase_gemm_naive(const bf16_t* __restrict__ A, const bf16_t* __restrict__ Bt, int N, bf16_t* __restrict__ Pout, const float* resid, float* out, int bid, int nb) {
    const size_t total = (size_t)NTOK * N;
    for (size_t e = (size_t)bid * NTHREADS + tidx(); e < total; e += (size_t)nb * NTHREADS) {
        const int t = (int)(e / N), n = (int)(e % N);
        const uint4* a = (const uint4*)(A + (size_t)t * DM); const uint4* b = (const uint4*)(Bt + (size_t)n * DM);
        float acc = 0.f;
        for (int c = 0; c < DM / 8; ++c) {
            const uint4 av = a[c], bv = b[c];
            const unsigned aw[4] = {av.x, av.y, av.z, av.w}, bw[4] = {bv.x, bv.y, bv.z, bv.w};
#pragma unroll
            for (int j = 0; j < 4; ++j) { acc = fmaf(__uint_as_float(aw[j] << 16), __uint_as_float(bw[j] << 16), acc); acc = fmaf(__uint_as_float(aw[j] & 0xFFFF0000u), __uint_as_float(bw[j] & 0xFFFF0000u), acc); }
        }
        if (MODE == 0) Pout[e] = f2bf(acc); else out[e] = resid[e] + acc;
    }
}


namespace pg8 {
#define PG8_LAS __attribute__((address_space(3)))
typedef short bf16x8 __attribute__((ext_vector_type(8)));
typedef float f32x4 __attribute__((ext_vector_type(4)));
typedef unsigned u32x4 __attribute__((ext_vector_type(4)));
constexpr int BM = 256, BK = 64, HALF = 128, HTB = HALF * BK * 2, STAGE_BYTES = 8 * HTB, NXCD = 8, WGM = 8;
DEV int lds_byte(int r, int c) { const int st = (r >> 4) * 2 + (c >> 5), rr = r & 15, cc = c & 31, ob = rr * 64 + cc * 2; return st * 1024 + (ob ^ (((ob >> 9) & 1) << 5)); }
DEV void stage_rc(int b, int& R, int& C) { const int st = b / 1024, sb = b % 1024, swz = sb ^ (((sb >> 9) & 1) << 5); R = (st >> 1) * 16 + swz / 64; C = (st & 1) * 32 + (swz % 64) / 2; }
DEV int perm32(int rho) { const int n = rho >> 4, i = rho & 15; return 8 * (i >> 2) + 4 * n + (i & 3); }
struct Unit { int pm, pn; };
struct Gemm { const bf16_t* A; const bf16_t* Bt; int M, N, K; };
struct StaticOrder {
    int nM, nN, nwg, G, c;
    DEV void init(int M, int N, int G_, int c_) { nM = M / BM; nN = N / BM; nwg = nM * nN; G = G_; c = c_; }
    DEV bool next(int i, Unit& u) const {
        const long L = (long)i * G + c; if (L >= nwg) return false;
        int wgid = (int)L; { const int q = nwg / NXCD, r = nwg % NXCD, xcd = wgid % NXCD, off = wgid / NXCD; wgid = (xcd < r ? xcd * (q + 1) : r * (q + 1) + (xcd - r) * q) + off; }
        const int nig = WGM * nN, gid = wgid / nig, fm = gid * WGM, gsz = (nM - fm) < WGM ? (nM - fm) : WGM;
        u.pm = fm + ((wgid % nig) % gsz); u.pn = (wgid % nig) / gsz; return true;
    }
};
DEV unsigned cvt_pk_bf16(float lo, float hi) { return cvt_pk_rne(lo, hi); }
struct EpiBf16 {
    static constexpr bool PERM = true, INIT_LOAD = false, HP = false;
    DEV void load(f32x4 (&)[2][2][4][2], const Unit&, int, int, int, int) const {}
    bf16_t* O; int ldc;
    DEV void operator()(const f32x4 (&acc)[2][2][4][2], const Unit& u, int wr, int wc, int fr, int fq) const {
        const int row0 = u.pm * BM + wr * 64 + fr, col0 = u.pn * BM + wc * 32 + 8 * fq;
#pragma unroll
        for (int ai = 0; ai < 2; ++ai)
#pragma unroll
            for (int m = 0; m < 4; ++m) { bf16_t* rowp = O + (size_t)(row0 + ai * HALF + m * 16) * ldc + col0;
#pragma unroll
                for (int bj = 0; bj < 2; ++bj) { const f32x4 v0 = acc[ai][bj][m][0], v1 = acc[ai][bj][m][1];
                    u32x4 w; w.x = cvt_pk_bf16(v0[0], v0[1]); w.y = cvt_pk_bf16(v0[2], v0[3]); w.z = cvt_pk_bf16(v1[0], v1[1]); w.w = cvt_pk_bf16(v1[2], v1[3]);
                    *(u32x4*)(rowp + bj * HALF) = w; } }
    }
};
struct EpiResF32 {
    static constexpr bool PERM = false, INIT_LOAD = true, HP = false;
    const float* R; float* C; int ldc;
    DEV void load(f32x4 (&acc)[2][2][4][2], const Unit& u, int wr, int wc, int fr, int fq) const {
        const int row0 = u.pm * BM + wr * 64 + fr, col0 = u.pn * BM + wc * 32 + 4 * fq;
#pragma unroll
        for (int ai = 0; ai < 2; ++ai)
#pragma unroll
            for (int m = 0; m < 4; ++m) { const size_t ro = (size_t)(row0 + ai * HALF + m * 16) * ldc + col0;
#pragma unroll
                for (int bj = 0; bj < 2; ++bj)
#pragma unroll
                    for (int n = 0; n < 2; ++n) acc[ai][bj][m][n] = *(const f32x4*)(R + ro + bj * HALF + n * 16); }
    }
    DEV void operator()(const f32x4 (&acc)[2][2][4][2], const Unit& u, int wr, int wc, int fr, int fq) const {
        const int row0 = u.pm * BM + wr * 64 + fr, col0 = u.pn * BM + wc * 32 + 4 * fq;
#pragma unroll
        for (int ai = 0; ai < 2; ++ai)
#pragma unroll
            for (int m = 0; m < 4; ++m) { const size_t ro = (size_t)(row0 + ai * HALF + m * 16) * ldc + col0;
#pragma unroll
                for (int bj = 0; bj < 2; ++bj)
#pragma unroll
                    for (int n = 0; n < 2; ++n) *(f32x4*)(C + ro + bj * HALF + n * 16) = acc[ai][bj][m][n]; }
    }
};
struct EpiBf16S {
    static constexpr bool PERM = true, INIT_LOAD = false, HP = true;
    DEV void load(f32x4 (&)[2][2][4][2], const Unit&, int, int, int, int) const {}
    bf16_t* O; int ldc; const PG8_LAS float* rtab; mutable int k; bf16_t* Vs; bf16_t* Vw; bf16_t* Ki; bf16_t* Ks; bf16_t* Kw; const float* gks; const float* gkw;
    DEV void operator()(const f32x4 (&acc)[2][2][4][2], const Unit& u, int wr, int wc, int fr, int fq) const {
        const int row0 = u.pm * BM + wr * 64 + fr, col0 = u.pn * BM + wc * 64 + 8 * fq;
        const PG8_LAS float* rt = rtab + k * BM + wr * 64 + fr; ++k;
        const bool kv = (u.pn == 12) || (u.pn == 13);
        const bool kdir = kv && wc < 2, vdir = kv && wc >= 2, kidir = (u.pn == 10) && wc == 2;
        float gk[2][8];
        if (kdir) { const float* gp = (u.pn == 12 ? gks : gkw) + 8 * fq;
#pragma unroll
            for (int bj = 0; bj < 2; ++bj) { const f32x4 a = *(const f32x4*)(gp + 32 * bj), b = *(const f32x4*)(gp + 32 * bj + 4);
                gk[bj][0] = a[0]; gk[bj][1] = a[1]; gk[bj][2] = a[2]; gk[bj][3] = a[3]; gk[bj][4] = b[0]; gk[bj][5] = b[1]; gk[bj][6] = b[2]; gk[bj][7] = b[3]; } }
        bf16_t* const kimg = (u.pn == 12 ? Ks : Kw) + (size_t)(wc & 1) * SEQ * 64 + fq * 512;
        bf16_t* const vimg = (u.pn == 12 ? Vs : Vw) + (size_t)(wc & 1) * SEQ * 64 + fq * 8;
#pragma unroll
        for (int ai = 0; ai < 2; ++ai)
#pragma unroll
            for (int m = 0; m < 4; ++m) {
                const int tok = row0 + ai * HALF + m * 16, bb = tok / SEQ, tt2 = tok % SEQ;
                bf16_t* rowp = O + (size_t)tok * ldc + col0; const float r = rt[ai * HALF + m * 16];
                float x[2][8];
#pragma unroll
                for (int bj = 0; bj < 2; ++bj) { const f32x4 v0 = acc[ai][bj][m][0], v1 = acc[ai][bj][m][1];
                    x[bj][0] = v0[0] * r; x[bj][1] = v0[1] * r; x[bj][2] = v0[2] * r; x[bj][3] = v0[3] * r; x[bj][4] = v1[0] * r; x[bj][5] = v1[1] * r; x[bj][6] = v1[2] * r; x[bj][7] = v1[3] * r; }
                if (kdir) {
                    float ss = 0.f;
#pragma unroll
                    for (int bj = 0; bj < 2; ++bj)
#pragma unroll
                        for (int j = 0; j < 8; ++j) ss = fmaf(x[bj][j], x[bj][j], ss);
                    ss += __shfl_xor(ss, 16); ss += __shfl_xor(ss, 32);
                    const float rk = __builtin_amdgcn_rsqf(ss * (1.f / 64.f) + EPS);
#pragma unroll
                    for (int bj = 0; bj < 2; ++bj)
#pragma unroll
                        for (int j = 0; j < 8; ++j) x[bj][j] = x[bj][j] * rk * gk[bj][j];
                }
#pragma unroll
                for (int bj = 0; bj < 2; ++bj) {
                    u32x4 w; w.x = cvt_pk_bf16(x[bj][0], x[bj][1]); w.y = cvt_pk_bf16(x[bj][2], x[bj][3]); w.z = cvt_pk_bf16(x[bj][4], x[bj][5]); w.w = cvt_pk_bf16(x[bj][6], x[bj][7]);
                    if (kdir) *(u32x4*)(kimg + (size_t)(bb * 2) * SEQ * 64 + (size_t)(tt2 >> 6) * 4096 + bj * 2048 + (tt2 & 63) * 8) = w;
                    else if (vdir) *(u32x4*)(vimg + (size_t)(bb * 2) * SEQ * 64 + (size_t)(tt2 >> 6) * 4096 + bj * 2048 + (tt2 & 63) * 32) = w;
                    else if (kidir) { const int kci = bj * 4 + fq; *(u32x4*)(Ki + ((size_t)(tok >> 5) * 4 + (kci >> 1)) * 512 + ((kci & 1) * 32 + (tok & 31)) * 8) = w; }
                    else *(u32x4*)(rowp + bj * 32) = w;
                }
            }
    }
};
template <bool RB, bool OB>
struct EpiRes {
    static constexpr bool PERM = true, INIT_LOAD = true, HP = false;
    const float* Rf; const bf16_t* Rb; float* Cf; bf16_t* Cb; int ldc; float* ssq;
    DEV void load(f32x4 (&acc)[2][2][4][2], const Unit& u, int wr, int wc, int fr, int fq) const {
        const int row0 = u.pm * BM + wr * 64 + fr, col0 = u.pn * BM + wc * 32 + 8 * fq;
#pragma unroll
        for (int ai = 0; ai < 2; ++ai)
#pragma unroll
            for (int m = 0; m < 4; ++m) { const size_t ro = (size_t)(row0 + ai * HALF + m * 16) * ldc + col0;
#pragma unroll
                for (int bj = 0; bj < 2; ++bj) {
                    if (RB) { const u32x4 w = *(const u32x4*)(Rb + ro + bj * HALF);
                        acc[ai][bj][m][0] = (f32x4){__uint_as_float(w.x << 16), __uint_as_float(w.x & 0xFFFF0000u), __uint_as_float(w.y << 16), __uint_as_float(w.y & 0xFFFF0000u)};
                        acc[ai][bj][m][1] = (f32x4){__uint_as_float(w.z << 16), __uint_as_float(w.z & 0xFFFF0000u), __uint_as_float(w.w << 16), __uint_as_float(w.w & 0xFFFF0000u)}; }
                    else { acc[ai][bj][m][0] = *(const f32x4*)(Rf + ro + bj * HALF); acc[ai][bj][m][1] = *(const f32x4*)(Rf + ro + bj * HALF + 4); } } }
    }
    DEV void operator()(const f32x4 (&acc)[2][2][4][2], const Unit& u, int wr, int wc, int fr, int fq) const {
        const int row0 = u.pm * BM + wr * 64 + fr, col0 = u.pn * BM + wc * 32 + 8 * fq;
#pragma unroll
        for (int ai = 0; ai < 2; ++ai)
#pragma unroll
            for (int m = 0; m < 4; ++m) { const size_t ro = (size_t)(row0 + ai * HALF + m * 16) * ldc + col0;
                float ss = 0.f;
#pragma unroll
                for (int bj = 0; bj < 2; ++bj) { const f32x4 v0 = acc[ai][bj][m][0], v1 = acc[ai][bj][m][1];
                    if (OB) { u32x4 w; w.x = cvt_pk_bf16(v0[0], v0[1]); w.y = cvt_pk_bf16(v0[2], v0[3]); w.z = cvt_pk_bf16(v1[0], v1[1]); w.w = cvt_pk_bf16(v1[2], v1[3]); *(u32x4*)(Cb + ro + bj * HALF) = w;
#pragma unroll
                        for (int e = 0; e < 4; ++e) { ss = fmaf(v0[e], v0[e], ss); ss = fmaf(v1[e], v1[e], ss); } }
                    else { *(f32x4*)(Cf + ro + bj * HALF) = v0; *(f32x4*)(Cf + ro + bj * HALF + 4) = v1; } }
                if (OB) {
                    ss += __shfl_xor(ss, 16); ss += __shfl_xor(ss, 32);
                    if (fq == 0) ssq[(size_t)(row0 + ai * HALF + m * 16) * 16 + u.pn * 4 + wc] = ss;
                } }
    }
};
template <class Epi, class Sched>
DEV void gemm_phase(PG8_LAS unsigned char* lds, const Gemm g, const Sched& S, const Epi& E) {
    const int tid = tidx(), wid = __builtin_amdgcn_readfirstlane(tid >> 6), lane = tid & 63, wr = wid >> 2, wc = wid & 3, fr = lane & 15, fq = lane >> 4;
    const int K = g.K, nt = K / BK;
    unsigned voffA[2], voffB[2];
#pragma unroll
    for (int i = 0; i < 2; ++i) { int R, C; stage_rc(tid * 16 + i * 8192, R, C); const int Rb = Epi::HP ? ((R >> 5) * 64 + perm32(R & 31)) : Epi::PERM ? ((R & ~31) + perm32(R & 31)) : R;
        voffA[i] = (unsigned)(R * K + C) * 2u; voffB[i] = (unsigned)(Rb * K + C) * 2u; }
    const size_t kstep = (size_t)(BK * 2);
    const size_t hstep = (size_t)HALF * K * 2;
    const size_t tstep = 2 * hstep;
    const size_t hstepB = Epi::HP ? (size_t)32 * K * 2 : hstep;
    const unsigned ldsw = (unsigned)wid * 1024u;
    const int aoff = lds_byte(wr * 64 + fr, fq * 8), boff = lds_byte(wc * 32 + fr, fq * 8);
#define PG8_SA(b, h) (((b) * 2 + (h)) * HTB)
#define PG8_SB(b, h) ((4 + (b) * 2 + (h)) * HTB)
#define PG8_STAGE(bufoff, gbase, voff) do { _Pragma("unroll") for (int _i = 0; _i < 2; ++_i) \
        __builtin_amdgcn_global_load_lds((const unsigned*)((const char*)(gbase) + (voff)[_i]), (PG8_LAS unsigned*)(lds + (bufoff) + ldsw + _i * 8192), 16, 0, 0); } while (0)
#define PG8_LDA(dst, b, h) do { _Pragma("unroll") for (int m = 0; m < 4; ++m) _Pragma("unroll") for (int k = 0; k < 2; ++k) dst[m][k] = *(const PG8_LAS bf16x8*)(lds + PG8_SA(b, h) + aoff + m * 2048 + k * 1024); } while (0)
#define PG8_LDB(dst, b, h) do { _Pragma("unroll") for (int n = 0; n < 2; ++n) _Pragma("unroll") for (int k = 0; k < 2; ++k) dst[n][k] = *(const PG8_LAS bf16x8*)(lds + PG8_SB(b, h) + boff + n * 2048 + k * 1024); } while (0)
#define PG8_MMA(ai, bj, At, Bt) do { __builtin_amdgcn_s_setprio(1); _Pragma("unroll") for (int m = 0; m < 4; ++m) _Pragma("unroll") for (int n = 0; n < 2; ++n) _Pragma("unroll") for (int k = 0; k < 2; ++k) \
        acc[ai][bj][m][n] = __builtin_amdgcn_mfma_f32_16x16x32_bf16(Bt[n][k], At[m][k], acc[ai][bj][m][n], 0, 0, 0); __builtin_amdgcn_s_setprio(0); } while (0)
#define PG8_WAIT_V(n) asm volatile("s_waitcnt vmcnt(" #n ")" ::: "memory")
#define PG8_WAIT_L(n) asm volatile("s_waitcnt lgkmcnt(" #n ")" ::: "memory")
#define PG8_BAR __builtin_amdgcn_s_barrier()
#define PG8_SCHED __builtin_amdgcn_sched_barrier(0)
    Unit cur, nxt; int ui = 0;
    if (!S.next(0, cur)) return;
    f32x4 acc[2][2][4][2];
    if (Epi::INIT_LOAD) E.load(acc, cur, wr, wc, fr, fq);
    else {
#pragma unroll
        for (int a = 0; a < 2; ++a)
#pragma unroll
            for (int b = 0; b < 2; ++b)
#pragma unroll
                for (int m = 0; m < 4; ++m)
#pragma unroll
                    for (int n = 0; n < 2; ++n) acc[a][b][m][n] = (f32x4){0.f, 0.f, 0.f, 0.f};
    }
    bf16x8 At[4][2], B0[2][2], B1[2][2];
    const char* cA = (const char*)g.A + (size_t)cur.pm * tstep; const char* cB = (const char*)g.Bt + (size_t)cur.pn * tstep;
    PG8_STAGE(PG8_SB(0, 0), cB, voffB); PG8_STAGE(PG8_SA(0, 0), cA, voffA); PG8_STAGE(PG8_SB(0, 1), cB + hstepB, voffB); PG8_STAGE(PG8_SA(0, 1), cA + hstep, voffA);
    if (wr == 1) PG8_BAR;
    PG8_WAIT_V(4); PG8_BAR;
    PG8_STAGE(PG8_SB(1, 0), cB + kstep, voffB); PG8_STAGE(PG8_SA(1, 0), cA + kstep, voffA); PG8_STAGE(PG8_SB(1, 1), cB + hstepB + kstep, voffB);
    PG8_WAIT_V(6); PG8_BAR;
    for (;;) {
        const bool has_next = S.next(ui + 1, nxt);
        const char* nA = has_next ? (const char*)g.A + (size_t)nxt.pm * tstep : cA; const char* nB = has_next ? (const char*)g.Bt + (size_t)nxt.pn * tstep : cB;
        for (int t = 0; t < nt; t += 2) {
            const bool last = (t == nt - 2);
            const char* a1 = cA + (size_t)(t + 1) * kstep;
            const char* a2 = last ? nA : cA + (size_t)(t + 2) * kstep; const char* b2 = last ? nB : cB + (size_t)(t + 2) * kstep;
            const char* a3 = a2 + kstep; const char* b3 = b2 + kstep;
            PG8_LDB(B0, 0, 0); PG8_SCHED; PG8_LDA(At, 0, 0); PG8_STAGE(PG8_SA(1, 1), a1 + hstep, voffA);
            PG8_WAIT_L(8); PG8_BAR; PG8_WAIT_L(0); PG8_MMA(0, 0, At, B0); PG8_BAR; PG8_SCHED;
            PG8_LDB(B1, 0, 1); PG8_STAGE(PG8_SB(0, 0), b2, voffB);
            PG8_BAR; PG8_WAIT_L(0); PG8_MMA(0, 1, At, B1); PG8_BAR;
            PG8_LDA(At, 0, 1); PG8_STAGE(PG8_SA(0, 0), a2, voffA);
            PG8_BAR; PG8_WAIT_L(0); PG8_MMA(1, 0, At, B0); PG8_BAR; PG8_SCHED;
            PG8_STAGE(PG8_SB(0, 1), b2 + hstepB, voffB);
            PG8_WAIT_V(6); PG8_BAR; PG8_MMA(1, 1, At, B1); PG8_BAR;
            PG8_LDB(B0, 1, 0); PG8_SCHED; PG8_LDA(At, 1, 0); PG8_STAGE(PG8_SA(0, 1), a2 + hstep, voffA);
            PG8_WAIT_L(8); PG8_BAR; PG8_WAIT_L(0); PG8_MMA(0, 0, At, B0); PG8_BAR; PG8_SCHED;
            PG8_LDB(B1, 1, 1); PG8_STAGE(PG8_SB(1, 0), b3, voffB);
            PG8_BAR; PG8_WAIT_L(0); PG8_MMA(0, 1, At, B1); PG8_BAR;
            PG8_LDA(At, 1, 1); PG8_STAGE(PG8_SA(1, 0), a3, voffA);
            PG8_BAR; PG8_WAIT_L(0); PG8_MMA(1, 0, At, B0); PG8_BAR; PG8_SCHED;
            PG8_STAGE(PG8_SB(1, 1), b3 + hstepB, voffB);
            PG8_WAIT_V(6); PG8_BAR; PG8_MMA(1, 1, At, B1); PG8_BAR;
        }
        E(acc, cur, wr, wc, fr, fq);
        if (!has_next) break;
        if (Epi::INIT_LOAD) E.load(acc, nxt, wr, wc, fr, fq);
        else {
#pragma unroll
            for (int a = 0; a < 2; ++a)
#pragma unroll
                for (int b = 0; b < 2; ++b)
#pragma unroll
                    for (int m = 0; m < 4; ++m)
#pragma unroll
                        for (int n = 0; n < 2; ++n) acc[a][b][m][n] = (f32x4){0.f, 0.f, 0.f, 0.f};
        }
        cur = nxt; cA = nA; cB = nB; ++ui;
    }
    PG8_WAIT_V(0);
    if (wr == 0) PG8_BAR;
    PG8_BAR;
#undef PG8_SA
#undef PG8_SB
#undef PG8_STAGE
#undef PG8_LDA
#undef PG8_LDB
#undef PG8_MMA
#undef PG8_WAIT_V
#undef PG8_WAIT_L
#undef PG8_BAR
#undef PG8_SCHED
}
}
DEV void phase_gemm_in(CP p, int l, int bid, int nb, char* lds) {
    pg8::StaticOrder S; S.init(NTOK, DP, nb, bid);
    {
        PG8_LAS float* rtab = (PG8_LAS float*)((PG8_LAS char*)lds + 131072);
        const int tid = tidx(), row = tid >> 1, h = tid & 1;
        for (int i = 0;; ++i) {
            pg8::Unit u; if (!S.next(i, u)) break;
            const pg8::f32x4* q = (const pg8::f32x4*)(p.ssq + (size_t)(u.pm * pg8::BM + row) * 16 + 8 * h);
            const pg8::f32x4 a = q[0], b = q[1];
            float t = ((a[0] + a[1]) + (a[2] + a[3])) + ((b[0] + b[1]) + (b[2] + b[3]));
            t += __shfl_xor(t, 1);
            if (h == 0) rtab[i * pg8::BM + row] = rsqrtf(t * (1.f / DM) + EPS);
        }
        __syncthreads();
        pg8::Gemm g{l == 0 ? p.xb : p.x1b, p.wt_in + (size_t)l * DP * DM, NTOK, DP, DM}; pg8::EpiBf16S E{p.P, PP, rtab, 0, p.Vs, p.Vw, p.Ki, p.Ks, p.Kw, p.k_norm_slc + l * 64, p.k_norm_win + l * 64}; pg8::gemm_phase((PG8_LAS unsigned char*)lds, g, S, E);
    }
}
DEV void phase_gemm_out(CP p, int l, int bid, int nb, char* lds, float* outp) {
    pg8::Gemm g{p.H, p.wt_out + (size_t)l * DM * DM, NTOK, DM, DM};
    pg8::StaticOrder S; S.init(NTOK, DM, nb, bid);
    if (l == 0) { pg8::EpiRes<true, true> E{nullptr, p.xb, nullptr, p.x1b, DM, p.ssq}; pg8::gemm_phase((PG8_LAS unsigned char*)lds, g, S, E); }
    else { pg8::EpiRes<true, false> E{nullptr, p.x1b, outp, nullptr, DM, nullptr}; pg8::gemm_phase((PG8_LAS unsigned char*)lds, g, S, E); }
}

DEV void head_norm_inplace(bf16_t* v, const float* __restrict__ g, int lane) {
    const float x = bf2f(v[lane]); const float r = rsqrtf(wave_sum(x * x) * (1.f / 64.f) + EPS); v[lane] = f2bf(x * r * g[lane]);
}
DEV void phase2_post_naive(CP p, int l, int bid, int nb, char* lds) {
    const int wid = tidx() >> 6, lane = tidx() & 63;
    float* cn = (float*)lds + wid * 128;
    for (int tok = bid * NWAVES + wid; tok < NTOK; tok += nb * NWAVES) {
        bf16_t* row = p.P + (size_t)tok * PP;
        for (int h = 0; h < 8; ++h) head_norm_inplace(row + C_QA + h * 64, p.q_norm_a + l * 64, lane);
        for (int h = 0; h < 8; ++h) head_norm_inplace(row + C_QB + h * 64, p.q_norm_b + l * 64, lane);
        for (int g = 0; g < 2; ++g) head_norm_inplace(row + C_KS + g * 64, p.k_norm_slc + l * 64, lane);
        for (int g = 0; g < 2; ++g) head_norm_inplace(row + C_KW + g * 64, p.k_norm_win + l * 64, lane);
        if (lane < 24) row[C_GB + lane] = f2bf(sigmoidf_(bf2f(row[C_GB + lane]) + p.b_gate_b[l * 24 + lane]));
        const float c0 = bf2f(row[C_CKV + lane]), c1 = bf2f(row[C_CKV + 64 + lane]);
        const float r = rsqrtf(wave_sum(c0 * c0 + c1 * c1) * (1.f / 128.f) + EPS);
        cn[lane] = c0 * r * p.kv_norm_a[l * 128 + lane]; cn[64 + lane] = c1 * r * p.kv_norm_a[l * 128 + 64 + lane];
        __builtin_amdgcn_wave_barrier();
        float o[4];
#pragma unroll
        for (int i = 0; i < 4; ++i) {
            const bf16_t* w = p.wt_kvup + (size_t)l * 256 * 128 + (size_t)(lane + 64 * i) * 128; float acc = 0.f;
            for (int k = 0; k < 128; ++k) acc = fmaf(cn[k], bf2f(w[k]), acc);
            o[i] = acc;
        }
        __builtin_amdgcn_wave_barrier();
#pragma unroll
        for (int g = 0; g < 2; ++g) {
            const float rr = rsqrtf(wave_sum(o[g] * o[g]) * (1.f / 64.f) + EPS);
            p.Ka[(size_t)tok * 128 + g * 64 + lane] = f2bf(o[g] * rr * p.k_norm_a[l * 64 + lane]);
            p.Va[(size_t)tok * 128 + g * 64 + lane] = f2bf(o[2 + g]);
        }
    }
    const int NCI = NBATCH * 2 * 2 * 256;
    for (int it = bid * NWAVES + wid; it < NCI; it += nb * NWAVES) {
        const int c = it & 255, kv = (it >> 8) & 1, g = (it >> 9) & 1, b = it >> 10;
        bf16_t* dst = (kv ? p.Vc : p.Kc) + ((size_t)(b * 2 + g) * 256 + c) * 64;
        if (c == 255) { dst[lane] = 0; continue; }
        const bf16_t* w1 = (kv ? p.wt_c1v : p.wt_c1k) + (size_t)l * 64 * 2048 + (size_t)lane * 2048;
        const int col = (kv ? C_VC : C_KC) + g * 64;
        float acc = 0.f;
        for (int j = 0; j < 32; ++j) {
            const bf16_t* xin = p.P + (size_t)(b * SEQ + 16 * c + j) * PP + col;
            for (int d = 0; d < 64; ++d) acc = fmaf(bf2f(xin[d]), bf2f(w1[j * 64 + d]), acc);
        }
        const float h1 = gelu_tanh(acc + (kv ? p.cbias_v : p.cbias_k)[l * 64 + lane]);
        const bf16_t* w2 = (kv ? p.wt_c2v : p.wt_c2k) + (size_t)l * 64 * 64 + (size_t)lane * 64;
        float o2 = 0.f;
        for (int n = 0; n < 64; ++n) o2 = fmaf(__shfl(h1, n), bf2f(w2[n]), o2);
        if (!kv) { const float rr = rsqrtf(wave_sum(o2 * o2) * (1.f / 64.f) + EPS); o2 = o2 * rr * p.k_norm_cmp[l * 64 + lane]; }
        dst[lane] = f2bf(o2);
    }
}

DEV void wave_kth_largest(const unsigned* keys, int n, int K, int lane, unsigned& T, int& cgt) {
    unsigned prefix = 0u;
    for (int bit = 31; bit >= 0; --bit) {
        const unsigned cand = prefix | (1u << bit);
        int cnt = 0;
        for (int i = lane; i < n; i += 64) cnt += (keys[i] >= cand) ? 1 : 0;
        cnt = wave_sum_i(cnt);
        if (cnt >= K) prefix = cand;
    }
    int c2 = 0;
    for (int i = lane; i < n; i += 64) c2 += (keys[i] > prefix) ? 1 : 0;
    T = prefix; cgt = wave_sum_i(c2);
}
DEV void wave_compact(const unsigned* keys, int n, int K, unsigned T, int cgt, int lane, int* sel) {
    int base = 0, eqseen = 0; const int need = K - cgt;
    const u64 lt = (lane == 0) ? 0ull : (~0ull >> (64 - lane));
    for (int i0 = 0; i0 < n; i0 += 64) {
        const int i = i0 + lane; const bool v = i < n; const unsigned k = v ? keys[i] : 0u;
        const bool gt = v && k > T, eq = v && k == T;
        const u64 beq = __ballot(eq); const int eqrank = eqseen + __popcll(beq & lt);
        const bool take = gt || (eq && eqrank < need);
        const u64 bt = __ballot(take); const int pos = base + __popcll(bt & lt);
        if (take) sel[pos] = i;
        base += __popcll(bt); eqseen += __popcll(beq);
    }
}

DEV void phase3_dsa_naive(CP p, int l, int bid, int nb, char* lds) {
    const int tid = tidx(), wid = tid >> 6, lane = tid & 63;
    unsigned* keys = (unsigned*)lds;
    float* qidx = (float*)(lds + 16384);
    float* qa = qidx + 512;
    float* wv = qa + 512;
    int* sel = (int*)(wv + 16);
    float* pw = (float*)(sel + 256);
    for (int item = bid; item < NTOK; item += nb) {
        const int b = item / SEQ, t = item % SEQ;
        const bf16_t* row = p.P + (size_t)item * PP;
        qidx[tid] = bf2f(row[C_QI + tid]); qa[tid] = bf2f(row[C_QA + tid]);
        if (tid < 8) wv[tid] = bf2f(row[C_WI + tid]) * 0.35355339059327373f;
        __syncthreads();
        const int n = t + 1;
        for (int s = tid; s < n; s += NTHREADS) {
            const bf16_t* kr = p.P + (size_t)(b * SEQ + s) * PP + C_KI;
            float sc = 0.f;
#pragma unroll 1
            for (int h = 0; h < 8; ++h) { const float d = dot64(kr, qidx + h * 64) * 0.125f; sc = fmaf(wv[h], fmaxf(d, 0.f), sc); }
            keys[s] = f2key(sc);
        }
        __syncthreads();
        int nsel;
        if (n <= 256) { nsel = n; if (tid < n) sel[tid] = tid; }
        else { nsel = 256; if (wid == 0) { unsigned T; int cgt; wave_kth_largest(keys, n, 256, lane, T, cgt); wave_compact(keys, n, 256, T, cgt, lane, sel); } }
        __syncthreads();
        {
            const int h = wid, g = h >> 2;
            float m = -INFINITY;
#pragma unroll 1
            for (int i = 0; i < 4; ++i) {
                const int j = lane + 64 * i; float v = -INFINITY;
                if (j < nsel) { const int s = sel[j]; v = dot64(p.Ka + (size_t)(b * SEQ + s) * 128 + g * 64, qa + h * 64) * 0.125f + p.biasd[h * 1024 + min(t - s, 1023)]; }
                pw[h * 256 + j] = v; m = fmaxf(m, v);
            }
            m = wave_max(m);
            float sum = 0.f;
#pragma unroll 1
            for (int i = 0; i < 4; ++i) { const int j = lane + 64 * i; const float v = pw[h * 256 + j]; const float e = (j < nsel) ? __expf(v - m) : 0.f; pw[h * 256 + j] = e; sum += e; }
            sum = wave_sum(sum); const float inv = 1.f / sum;
            __builtin_amdgcn_wave_barrier();
            float o = 0.f;
            for (int j = 0; j < nsel; ++j) o = fmaf(pw[h * 256 + j], bf2f(p.Va[(size_t)(b * SEQ + sel[j]) * 128 + g * 64 + lane]), o);
            o *= inv;
            const float z = bf2f(row[C_ZA + h * 64 + lane]);
            p.H[(size_t)item * DM + h * 64 + lane] = f2bf(o * silu(z));
        }
        __syncthreads();
    }
}

DEV void phase3_nsa_naive(CP p, int l, int bid, int nb, char* lds) {
    const int tid = tidx(), wid = tid >> 6, lane = tid & 63;
    float* qb = (float*)lds;
    float* pc = qb + 512;
    float* lgs = pc + 2048;
    float* imp = lgs + 8192;
    int* selflag = (int*)(imp + 128);
    int* sblk = selflag + 128;
    int* nsb = sblk + 32;
    for (int item = bid; item < NTOK; item += nb) {
        const int b = item / SEQ, t = item % SEQ;
        const bf16_t* row = p.P + (size_t)item * PP;
        qb[tid] = bf2f(row[C_QB + tid]);
        __syncthreads();
        const int h = wid, g = h >> 2;
        const float* q = qb + h * 64;
        const float* bd = p.biasd + (8 + h) * 1024;
        float oc = 0.f;
        {
            float m = -INFINITY;
#pragma unroll 1
            for (int i = 0; i < 4; ++i) {
                const int c = lane + 64 * i; const int dist = t - (16 * c + 31); float v = -INFINITY;
                if (c < 255 && dist >= 0) v = dot64(p.Kc + ((size_t)(b * 2 + g) * 256 + c) * 64, q) * 0.125f + bd[min(dist, 1023)];
                pc[h * 256 + c] = v; m = fmaxf(m, v);
            }
            m = wave_max(m);
            float sum = 0.f;
#pragma unroll 1
            for (int i = 0; i < 4; ++i) { const int c = lane + 64 * i; const float v = pc[h * 256 + c]; const float e = (v > -INFINITY) ? __expf(v - m) : 0.f; pc[h * 256 + c] = e; sum += e; }
            sum = wave_sum(sum); const float inv = sum > 0.f ? 1.f / sum : 0.f;
#pragma unroll 1
            for (int i = 0; i < 4; ++i) pc[h * 256 + lane + 64 * i] *= inv;
            __builtin_amdgcn_wave_barrier();
            const int ncv = (t >= 31) ? min(255, (t - 31) / 16 + 1) : 0;
            for (int c = 0; c < ncv; ++c) oc = fmaf(pc[h * 256 + c], bf2f(p.Vc[((size_t)(b * 2 + g) * 256 + c) * 64 + lane]), oc);
        }
        __syncthreads();
        const int jt = t >> 6;
        if (tid < 128) {
            const int gg = tid >> 6, n = tid & 63; float s = 0.f;
#pragma unroll
            for (int r = 0; r < 4; ++r) { const float* pr = pc + (gg * 4 + r) * 256; s += pr[4 * n] + pr[4 * n + 1] + pr[4 * n + 2] + 0.5f * pr[4 * n + 3] + (n > 0 ? 0.5f * pr[4 * n - 1] : 0.f); }
            if (n == 0 || n == jt || n == jt - 1) s += 1e4f;
            if (n * 64 > t) s = -INFINITY;
            imp[tid] = s;
        }
        __syncthreads();
        if (tid < 128) {
            const int gg = tid >> 6, n = tid & 63; const float v = imp[tid]; int rank = 0;
            for (int m2 = 0; m2 < 64; ++m2) { const float u = imp[gg * 64 + m2]; rank += (u > v || (u == v && m2 < n)) ? 1 : 0; }
            selflag[tid] = (rank < 16 && n * 64 <= t) ? 1 : 0;
        }
        __syncthreads();
        if (tid < 128) {
            const int gg = tid >> 6, n = tid & 63;
            if (selflag[tid]) { int pos = 0; for (int m2 = 0; m2 < n; ++m2) pos += selflag[gg * 64 + m2]; sblk[gg * 16 + pos] = n; }
            if (n == 0) { int c = 0; for (int m2 = 0; m2 < 64; ++m2) c += selflag[gg * 64 + m2]; nsb[gg] = c; }
        }
        __syncthreads();
        float os = 0.f;
        {
            const int ns = nsb[g]; float m = -INFINITY;
            for (int j = 0; j < ns; ++j) {
                const int s = sblk[g * 16 + j] * 64 + lane; float v = -INFINITY;
                if (s <= t) v = dot64(p.P + (size_t)(b * SEQ + s) * PP + C_KS + g * 64, q) * 0.125f + bd[min(t - s, 1023)];
                lgs[h * 1024 + j * 64 + lane] = v; m = fmaxf(m, v);
            }
            m = wave_max(m); float sum = 0.f;
            for (int j = 0; j < ns; ++j) { const float v = lgs[h * 1024 + j * 64 + lane]; const float e = (v > -INFINITY) ? __expf(v - m) : 0.f; lgs[h * 1024 + j * 64 + lane] = e; sum += e; }
            sum = wave_sum(sum); const float inv = sum > 0.f ? 1.f / sum : 0.f;
            __builtin_amdgcn_wave_barrier();
            for (int j = 0; j < ns; ++j) {
                const int s0 = sblk[g * 16 + j] * 64;
                for (int k = 0; k < 64; ++k) { if (s0 + k > t) break; os = fmaf(lgs[h * 1024 + j * 64 + k], bf2f(p.P[(size_t)(b * SEQ + s0 + k) * PP + C_VS + g * 64 + lane]), os); }
            }
            os *= inv;
            __builtin_amdgcn_wave_barrier();
        }
        float ow = 0.f;
        {
            const int s0 = max(0, t - 511); float m = -INFINITY;
#pragma unroll 1
            for (int i = 0; i < 8; ++i) {
                const int s = s0 + lane + 64 * i; float v = -INFINITY;
                if (s <= t) v = dot64(p.P + (size_t)(b * SEQ + s) * PP + C_KW + g * 64, q) * 0.125f + bd[t - s];
                lgs[h * 1024 + lane + 64 * i] = v; m = fmaxf(m, v);
            }
            m = wave_max(m); float sum = 0.f;
#pragma unroll 1
            for (int i = 0; i < 8; ++i) { const float v = lgs[h * 1024 + lane + 64 * i]; const float e = (v > -INFINITY) ? __expf(v - m) : 0.f; lgs[h * 1024 + lane + 64 * i] = e; sum += e; }
            sum = wave_sum(sum); const float inv = 1.f / sum;
            __builtin_amdgcn_wave_barrier();
            const int cnt = t - s0 + 1;
            for (int k = 0; k < cnt; ++k) ow = fmaf(lgs[h * 1024 + k], bf2f(p.P[(size_t)(b * SEQ + s0 + k) * PP + C_VW + g * 64 + lane]), ow);
            ow *= inv;
        }
        const float gc = bf2f(row[C_GB + h * 3 + 0]), gs = bf2f(row[C_GB + h * 3 + 1]), gw = bf2f(row[C_GB + h * 3 + 2]);
        const float o = gc * oc + gs * os + gw * ow;
        const float z = bf2f(row[C_ZB + h * 64 + lane]);
        p.H[(size_t)item * DM + 512 + h * 64 + lane] = f2bf(o * silu(z));
        __syncthreads();
    }
}


namespace nsa {
typedef unsigned u32x2 __attribute__((ext_vector_type(2)));
#define LAS __attribute__((address_space(3)))
typedef short bf16x8 __attribute__((ext_vector_type(8)));
typedef short s16x4 __attribute__((ext_vector_type(4)));
typedef float f32x16 __attribute__((ext_vector_type(16)));
typedef unsigned u32x4 __attribute__((ext_vector_type(4)));
constexpr float LOG2E = 1.4426950408889634f, C2 = 0.125f * LOG2E, M0 = 8.0f;
constexpr int RT_STRIDE = 1160, RT_NEG = 1088;
constexpr int L_K = 0, L_V = 16384, L_BIAS = 32768, L_IMP = L_BIAS + 4 * RT_STRIDE * 4, IMP_Q = 68, L_WGM = L_IMP + 8 * 8 * 2 * IMP_Q * 4, L_OF = L_WGM + 128, L_END = L_OF + 8 * 8192;
DEV f32x16 MF(bf16x8 a, bf16x8 b, f32x16 c) { return __builtin_amdgcn_mfma_f32_32x32x16_bf16(a, b, c, 0, 0, 0); }
DEV float swap_max(float v) { auto rr = __builtin_amdgcn_permlane32_swap(__float_as_uint(v), __float_as_uint(v), false, false); return fmaxf(__uint_as_float(rr[0]), __uint_as_float(rr[1])); }
DEV float swap_sum(float v) { auto rr = __builtin_amdgcn_permlane32_swap(__float_as_uint(v), __float_as_uint(v), false, false); return __uint_as_float(rr[0]) + __uint_as_float(rr[1]); }
DEV float ex2(float x) { return __builtin_amdgcn_exp2f(x); }
template <int SUB>
DEV void vtr8(const LAS char* vb, s16x4 (&va)[2][2][2]) {
    long r0, r1, r2, r3, r4, r5, r6, r7;
    constexpr int B = 32 * SUB * 64;
    asm volatile("ds_read_b64_tr_b16 %0, %8 offset:%9\n\tds_read_b64_tr_b16 %1, %8 offset:%10\n\tds_read_b64_tr_b16 %2, %8 offset:%11\n\tds_read_b64_tr_b16 %3, %8 offset:%12\n\t"
                 "ds_read_b64_tr_b16 %4, %8 offset:%13\n\tds_read_b64_tr_b16 %5, %8 offset:%14\n\tds_read_b64_tr_b16 %6, %8 offset:%15\n\tds_read_b64_tr_b16 %7, %8 offset:%16\n\ts_waitcnt lgkmcnt(0)"
                 : "=&v"(r0), "=&v"(r1), "=&v"(r2), "=&v"(r3), "=&v"(r4), "=&v"(r5), "=&v"(r6), "=&v"(r7)
                 : "v"(vb), "n"(B), "n"(B + 512), "n"(B + 4096), "n"(B + 4096 + 512), "n"(B + 1024), "n"(B + 1024 + 512), "n"(B + 4096 + 1024), "n"(B + 4096 + 1024 + 512)
                 : "memory");
    va[0][0][0] = __builtin_bit_cast(s16x4, r0); va[0][0][1] = __builtin_bit_cast(s16x4, r1); va[0][1][0] = __builtin_bit_cast(s16x4, r2); va[0][1][1] = __builtin_bit_cast(s16x4, r3);
    va[1][0][0] = __builtin_bit_cast(s16x4, r4); va[1][0][1] = __builtin_bit_cast(s16x4, r5); va[1][1][0] = __builtin_bit_cast(s16x4, r6); va[1][1][1] = __builtin_bit_cast(s16x4, r7);
}
DEV float quad_sum(float v) {
    v += __int_as_float(__builtin_amdgcn_update_dpp(0, __float_as_int(v), 0xB1, 0xF, 0xF, true));
    v += __int_as_float(__builtin_amdgcn_update_dpp(0, __float_as_int(v), 0x4E, 0xF, 0xF, true));
    return v;
}
typedef short v4i16_t __attribute__((ext_vector_type(4)));
DEV s16x4 vtr(const LAS char* p) { return __builtin_bit_cast(s16x4, __builtin_amdgcn_ds_read_tr16_b64_v4i16((LAS v4i16_t*)p)); }
DEV unsigned cvtpk(float lo, float hi) { return cvt_pk_rne(lo, hi); }

DEV void pv_half(const f32x16& s, int sub, const LAS char* vbuf, f32x16& o0, f32x16& o1, int hi, int lane) {
    const int q4 = (lane & 15) >> 2, p4 = lane & 3, dh = (lane >> 4) & 1;
    const LAS char* vb = vbuf + (4 * hi + q4) * 64 + 32 * dh + 8 * p4;
    s16x4 va[2][2][2];
    if (sub == 0) vtr8<0>(vb, va); else vtr8<1>(vb, va);
#pragma unroll
    for (int s2 = 0; s2 < 2; ++s2) {
        union { unsigned u[4]; bf16x8 v; } pb;
#pragma unroll
        for (int j = 0; j < 4; ++j) pb.u[j] = cvtpk(s[8 * s2 + 2 * j], s[8 * s2 + 2 * j + 1]);
#pragma unroll
        for (int mt = 0; mt < 2; ++mt) {
            const bf16x8 vf = __builtin_shufflevector(va[s2][mt][0], va[s2][mt][1], 0, 1, 2, 3, 4, 5, 6, 7);
            if (mt == 0) o0 = MF(vf, pb.v, o0); else o1 = MF(vf, pb.v, o1);
        }
    }
}
DEV void qk_half(f32x16& s, int sub, const LAS char* kbuf, const bf16x8 (&qf)[4], int r32, int hi) {
    bf16x8 kf[4];
#pragma unroll
    for (int ks = 0; ks < 4; ++ks) kf[ks] = *(const LAS bf16x8*)(kbuf + (2 * ks + hi) * 1024 + (32 * sub + r32) * 16);
    asm volatile("" : "+v"(kf[0]), "+v"(kf[1]), "+v"(kf[2]), "+v"(kf[3]));
#pragma unroll
    for (int ks = 0; ks < 4; ++ks) s = MF(kf[ks], qf[ks], s);
}
template <int PASS>
DEV void cmp_tile(const LAS char* kbuf, const LAS char* vbuf, int key0, int t, const LAS float* rt, const bf16x8 (&qf)[4],
                  float& l, f32x16& o0, f32x16& o1, float invl, LAS float* impq, int r32, int hi, int lane) {
    float sum = 0.f;
#pragma unroll
    for (int sub = 0; sub < 2; ++sub) {
        f32x16 s;
        const int ix0 = 1023 - (t - 16 * (key0 + 32 * sub + 4 * hi) - 31);
#pragma unroll
        for (int r = 0; r < 16; ++r) s[r] = rt[min(max(ix0 + 16 * ((r & 3) + 8 * (r >> 2)), 0), 1024)];
        qk_half(s, sub, kbuf, qf, r32, hi);
#pragma unroll
        for (int r = 0; r < 16; ++r) {
            float e = ex2(s[r]);
            if (PASS == 1) e *= invl;
            s[r] = e; sum += e;
        }
        if (PASS == 1) {
            pv_half(s, sub, vbuf, o0, o1, hi, lane);
#pragma unroll
            for (int i = 0; i < 4; ++i) {
                const int n = (key0 >> 2) + 8 * sub + 2 * i + hi;
                float p3 = 0.5f * s[4 * i + 3];
                float mainv = (s[4 * i] + s[4 * i + 1]) + (s[4 * i + 2] + p3);
                mainv = quad_sum(mainv); p3 = quad_sum(p3);
                if ((lane & 3) == 0) { impq[n] = mainv; impq[IMP_Q + n + 1] = p3; }
            }
        }
        __builtin_amdgcn_sched_barrier(0);
    }
    if (PASS == 0) l += sum;
}
template <bool FAR, int MK>
DEV void hot_tile(const LAS char* kbuf, const LAS char* vbuf, int tl, float cb, const LAS float* rtb, const bf16x8 (&qf)[4],
                  float& l, f32x16& o0, f32x16& o1, int r32, int hi, int lane) {
    const int q4 = (lane & 15) >> 2, p4 = lane & 3, dh = (lane >> 4) & 1;
    const LAS char* vb = vbuf + (4 * hi + q4) * 64 + 32 * dh + 8 * p4;
    f32x16 s0, s1;
    bf16x8 kf[4];
#pragma unroll
    for (int r = 0; r < 16; ++r) s0[r] = FAR ? cb : rtb[8 * (r >> 2) + (r & 3)];
#pragma unroll
    for (int ks = 0; ks < 4; ++ks) kf[ks] = *(const LAS bf16x8*)(kbuf + (2 * ks + hi) * 1024 + r32 * 16);
#pragma unroll
    for (int ks = 0; ks < 4; ++ks) s0 = MF(kf[ks], qf[ks], s0);
#pragma unroll
    for (int r = 0; r < 16; ++r) s1[r] = FAR ? cb : rtb[32 + 8 * (r >> 2) + (r & 3)];
#pragma unroll
    for (int ks = 0; ks < 4; ++ks) kf[ks] = *(const LAS bf16x8*)(kbuf + (2 * ks + hi) * 1024 + (32 + r32) * 16);
    __builtin_amdgcn_sched_barrier(0);
    float sum = 0.f;
    unsigned pk[8];
#define NSA_EXPS(s, sub) do { _Pragma("unroll") for (int r = 0; r < 16; r += 2) { float v0 = s[r], v1 = s[r + 1]; \
        if (MK == 1) { const int kl = 32 * (sub) + (r & 3) + 8 * (r >> 2) + 4 * hi; v0 = (kl <= tl) ? v0 : -INFINITY; v1 = (kl + 1 <= tl) ? v1 : -INFINITY; } \
        if (MK == 2) { const int kl = 32 * (sub) + (r & 3) + 8 * (r >> 2) + 4 * hi; v0 = (kl > tl - 512) ? v0 : -INFINITY; v1 = (kl + 1 > tl - 512) ? v1 : -INFINITY; } \
        const float e0 = ex2(v0), e1 = ex2(v1); sum += e0; sum += e1; pk[r >> 1] = cvtpk(e0, e1); } } while (0)
#define NSA_PV(sub) do { _Pragma("unroll") for (int s2 = 0; s2 < 2; ++s2) { union { unsigned u[4]; bf16x8 v; } pb; \
        _Pragma("unroll") for (int j = 0; j < 4; ++j) pb.u[j] = pk[4 * s2 + j]; \
        _Pragma("unroll") for (int mt = 0; mt < 2; ++mt) { const bf16x8 vf = __builtin_shufflevector(va[s2][mt][0], va[s2][mt][1], 0, 1, 2, 3, 4, 5, 6, 7); \
            if (mt == 0) o0 = MF(vf, pb.v, o0); else o1 = MF(vf, pb.v, o1); } } } while (0)
#define NSA_VRD(sub) vtr8<sub>(vb, va)
    NSA_EXPS(s0, 0);
#pragma unroll
    for (int ks = 0; ks < 4; ++ks) s1 = MF(kf[ks], qf[ks], s1);
    s16x4 va[2][2][2];
    NSA_VRD(0);
    __builtin_amdgcn_sched_barrier(0);
    NSA_PV(0);
    NSA_VRD(1);
    NSA_EXPS(s1, 1);
    __builtin_amdgcn_sched_barrier(0);
    NSA_PV(1);
#undef NSA_EXPS
#undef NSA_PV
#undef NSA_VRD
    l += sum;
}
}

#ifdef SELFCHECK
#define NSA_CK(slot, expr) do { unsigned c_ = 0u; expr; _Pragma("unroll") for (int o_ = 1; o_ < 64; o_ <<= 1) c_ += __shfl_xor(c_, o_); if (lane == 0) atomicAdd(p.chk + 32 + pass * 8 + (slot), (unsigned long long)c_); } while (0)
#else
#define NSA_CK(slot, expr) do {} while (0)
#endif
DEV void phase3_nsa_fast(CP p, int l, int bid, int nb, char* lds_, int pass = 0) {
    using namespace nsa;
    LAS char* lds = (LAS char*)lds_;
    const int tid = tidx(), lane = tid & 63, r32 = lane & 31, hi = lane >> 5;
    const int wid = __builtin_amdgcn_readfirstlane(tid >> 6);
    constexpr int R_SLOT = 16384, L_RT = 4 * R_SLOT, L_WV = L_RT + 4 * RT_STRIDE * 4, L_WG = L_WV + 8 * 8192;
    LAS float* rt_l = (LAS float*)(lds + L_RT);
    LAS float* impw = (LAS float*)(lds + L_WV + wid * 8192);
    LAS float* ofs = impw + lane;
    LAS unsigned* wgm = (LAS unsigned*)(lds + L_WG);
    int sl = 0, g_tab = -1;
    const unsigned stoff = (unsigned)(tid * 16);
#define NSA_DMA(gbase, goff, slot, isv) do { const char* sb_ = (gbase) + (goff); asm volatile("" : "+s"(sb_));     \
        __builtin_amdgcn_global_load_lds((const unsigned*)(sb_ + stoff), (LAS unsigned*)(lds + (slot) * R_SLOT + (isv) * 8192 + wid * 1024), 16, 0, 0); } while (0)
#define NSA_WAIT(n) asm volatile("s_waitcnt vmcnt(" #n ")" ::: "memory")
#define NSA_BAR() do { asm volatile("" ::: "memory"); __builtin_amdgcn_s_barrier(); asm volatile("" ::: "memory"); } while (0)
#define NSA_NEXT(x) (((x) + 1) & 3)
    unsigned* const qctr = p.ctrl + NSAQ_WORD + l * 16 + (bid & 15);
    LAS int* const qnx = (LAS int*)(lds + L_WG + 16);
    if (tid == 0) qnx[0] = (int)__hip_atomic_fetch_add(qctr, 1u, __ATOMIC_RELAXED, __HIP_MEMORY_SCOPE_AGENT);
    __syncthreads();
    for (int kq_ = __builtin_amdgcn_readfirstlane(qnx[0]); kq_ < 64; ) {
        int knext = 0;
        if (tid == 0) knext = (int)__hip_atomic_fetch_add(qctr, 1u, __ATOMIC_RELAXED, __HIP_MEMORY_SCOPE_AGENT);
        const int b = bid & 7, g = (bid >> 3) & 1;
        const int qt = 63 - kq_;
        const int q0 = qt * 64;
        const int ql = r32 >> 2, rh = r32 & 3, head = g * 4 + rh;
        const int t = q0 + wid * 8 + ql;
        const size_t tokrow = (size_t)(b * SEQ + t);
        const bf16_t* prow = p.P + tokrow * PP;
        if (g != g_tab) {
            for (int e = tid; e < 4 * 1152; e += NTHREADS) {
                const int h = e / 1152, jj = e % 1152;
                float v = -INFINITY;
                if (jj < 1024) v = p.biasd[(8 + g * 4 + h) * 1024 + (1023 - jj)] * LOG2E - M0;
                rt_l[h * RT_STRIDE + jj] = v;
            }
            g_tab = g;
        }
        for (int e = lane; e < 8 * 2 * IMP_Q; e += 64) impw[e] = 0.f;
        if (tid < 2) wgm[tid] = 0u;
        const LAS float* rt = rt_l + rh * RT_STRIDE;
        bf16x8 qf[4];
#pragma unroll
        for (int ks = 0; ks < 4; ++ks) qf[ks] = *(const bf16x8*)(prow + C_QB + head * 64 + 16 * ks + 8 * hi);
        float4 gqn[4][2];
#pragma unroll
        for (int ks = 0; ks < 4; ++ks) { const float* gq = p.q_norm_b + l * 64 + 16 * ks + 8 * hi; gqn[ks][0] = *(const float4*)gq; gqn[ks][1] = *(const float4*)(gq + 4); }
        const bf16_t gcr = prow[C_GB + head * 3 + 0], gsr = prow[C_GB + head * 3 + 1], gwr = prow[C_GB + head * 3 + 2];
        const char* Kc = (const char*)(p.Kc + (size_t)(b * 2 + g) * 256 * 64); const char* Vc = (const char*)(p.Vc + (size_t)(b * 2 + g) * 256 * 64);
        const int ntc = (4 * qt + 3 + 63) / 64;
        NSA_DMA(Kc, 0u, sl, 0); if (ntc > 1) NSA_DMA(Kc, 8192u, NSA_NEXT(sl), 0);
        {
            float xq[4][8]; float ss = 0.f;
#pragma unroll
            for (int ks = 0; ks < 4; ++ks) { unpack8g(__builtin_bit_cast(uint4, qf[ks]), xq[ks]);
#pragma unroll
                for (int jx = 0; jx < 8; ++jx) ss = fmaf(xq[ks][jx], xq[ks][jx], ss); }
            ss = swap_sum(ss);
            const float rq = rsqrtf(ss * (1.f / 64.f) + EPS) * C2;
#pragma unroll
            for (int ks = 0; ks < 4; ++ks) {
                const float4 g0 = gqn[ks][0], g1 = gqn[ks][1];
                union { unsigned u[4]; bf16x8 v; } pk;
                pk.u[0] = cvtpk(xq[ks][0] * rq * g0.x, xq[ks][1] * rq * g0.y); pk.u[1] = cvtpk(xq[ks][2] * rq * g0.z, xq[ks][3] * rq * g0.w);
                pk.u[2] = cvtpk(xq[ks][4] * rq * g1.x, xq[ks][5] * rq * g1.y); pk.u[3] = cvtpk(xq[ks][6] * rq * g1.z, xq[ks][7] * rq * g1.w);
                qf[ks] = pk.v;
            }
        }
        const float gc = bf2f(gcr), gs = bf2f(gsr), gw = bf2f(gwr);
        f32x16 o0, o1;
#pragma unroll
        for (int r = 0; r < 16; ++r) { o0[r] = 0.f; o1[r] = 0.f; }
        __syncthreads();
        float lc = 0.f;
        {
            int s0 = sl, s1 = NSA_NEXT(sl);
            for (int i = 0; i < ntc; ++i) {
                if (i + 1 < ntc) NSA_WAIT(1); else NSA_WAIT(0);
                NSA_BAR();
                const int s2 = NSA_NEXT(s1);
                if (i + 2 < ntc) NSA_DMA(Kc, (unsigned)((i + 2) * 8192), s2, 0);
                cmp_tile<0>(lds + s0 * R_SLOT, nullptr, 64 * i, t, rt, qf, lc, o0, o1, 0.f, nullptr, r32, hi, lane);
                s0 = s1; s1 = s2;
            }
            sl = s0;
        }
        {
            const float lt = swap_sum(lc); const float invl = lt > 0.f ? 1.f / lt : 0.f;
            LAS float* impq = impw + ql * 2 * IMP_Q;
            float ldummy = 0.f;
            int s0 = sl, s1 = NSA_NEXT(sl);
            NSA_DMA(Kc, 0u, s0, 0); NSA_DMA(Vc, 0u, s0, 1); if (ntc > 1) { NSA_DMA(Kc, 8192u, s1, 0); NSA_DMA(Vc, 8192u, s1, 1); }
            for (int i = 0; i < ntc; ++i) {
                if (i + 1 < ntc) NSA_WAIT(2); else NSA_WAIT(0);
                NSA_BAR();
                const int s2 = NSA_NEXT(s1);
                if (i + 2 < ntc) { NSA_DMA(Kc, (unsigned)((i + 2) * 8192), s2, 0); NSA_DMA(Vc, (unsigned)((i + 2) * 8192), s2, 1); }
                cmp_tile<1>(lds + s0 * R_SLOT, lds + s0 * R_SLOT + 8192, 64 * i, t, rt, qf, ldummy, o0, o1, invl, impq, r32, hi, lane);
                s0 = s1; s1 = s2;
            }
            sl = s0;
        }
        u64 mask;
        if (qt < 16) { mask = (2ull << qt) - 1ull; if (lane == 0) { __hip_atomic_fetch_or(wgm, (unsigned)mask, __ATOMIC_RELAXED, __HIP_MEMORY_SCOPE_WORKGROUP); } }
        else {
            const int rq = lane >> 3, part = lane & 7;
            LAS float* iq = impw + rq * 2 * IMP_Q;
            int v[8];
#pragma unroll
            for (int e = 0; e < 8; ++e) { const int n = e * 8 + part; float x = iq[n] + iq[IMP_Q + n]; if (n == 0 || n == qt || n == qt - 1) x += 1e4f; if (n > qt) x = -INFINITY; v[e] = (__float_as_int(x) & ~63) | (63 - n); }
            __builtin_amdgcn_wave_barrier();
            LAS int* iqi = (LAS int*)iq;
#pragma unroll
            for (int e = 0; e < 8; ++e) iqi[e * 8 + part] = v[e];
            __builtin_amdgcn_wave_barrier();
            int cnt[8];
#pragma unroll
            for (int e = 0; e < 8; ++e) cnt[e] = 0;
#pragma unroll 4
            for (int jj = 0; jj <= qt; ++jj) {
                const int u = iqi[jj];
#pragma unroll
                for (int e = 0; e < 8; ++e) cnt[e] += (u > v[e]) ? 1 : 0;
            }
            u64 m64 = 0ull, un = 0ull;
#pragma unroll
            for (int e = 0; e < 8; ++e) {
                const u64 bal = __ballot(cnt[e] < 16 && (e * 8 + part) <= qt);
                m64 |= ((bal >> (8 * ql)) & 0xFFull) << (8 * e);
                u64 f = bal | (bal >> 32); f |= f >> 16; f |= f >> 8;
                un |= (f & 0xFFull) << (8 * e);
            }
            mask = m64;
            if (lane == 0) { __hip_atomic_fetch_or(wgm, (unsigned)un, __ATOMIC_RELAXED, __HIP_MEMORY_SCOPE_WORKGROUP); __hip_atomic_fetch_or(wgm + 1, (unsigned)(un >> 32), __ATOMIC_RELAXED, __HIP_MEMORY_SCOPE_WORKGROUP); }
        }
        NSA_CK(0, c_ += (unsigned)mask + (unsigned)(mask >> 32));
        __builtin_amdgcn_wave_barrier();
#pragma unroll
        for (int r = 0; r < 16; ++r) { ofs[r * 64] = gc * o0[r]; ofs[(16 + r) * 64] = gc * o1[r]; o0[r] = 0.f; o1[r] = 0.f; }
        __syncthreads();
        const int tmin = q0 + wid * 8;
        const float cb31 = rt[0];
        const char* Kwb = (const char*)(p.Kw + (size_t)(b * 2 + g) * SEQ * 64); const char* Vwb = (const char*)(p.Vw + (size_t)(b * 2 + g) * SEQ * 64);
        const int nlo = max(0, qt - 8);
        int wpre = 0;
        {
            u64 todo = (u64)wgm[0] | ((u64)wgm[1] << 32);
            float ls = 0.f;
            const char* Kb = (const char*)(p.Ks + (size_t)(b * 2 + g) * SEQ * 64); const char* Vb = (const char*)(p.Vs + (size_t)(b * 2 + g) * SEQ * 64);
            int rb = sl;
            int a0 = (int)__builtin_ctzll(todo); todo &= todo - 1;
            int a1 = todo ? (int)__builtin_ctzll(todo) : -1; if (a1 >= 0) todo &= todo - 1;
            NSA_DMA(Kb, (unsigned)(a0 * 8192), rb, 0); NSA_DMA(Vb, (unsigned)(a0 * 8192), rb, 1);
            if (a1 >= 0) { NSA_DMA(Kb, (unsigned)(a1 * 8192), NSA_NEXT(rb), 0); NSA_DMA(Vb, (unsigned)(a1 * 8192), NSA_NEXT(rb), 1); }
            for (;;) {
                const int c0 = todo ? (int)__builtin_ctzll(todo) : -1; if (c0 >= 0) todo &= todo - 1;
                const int c1 = (c0 >= 0 && todo) ? (int)__builtin_ctzll(todo) : -1; if (c1 >= 0) todo &= todo - 1;
                NSA_WAIT(0);
                NSA_BAR();
                const int nb0 = (rb + 2) & 3, nb1 = (rb + 3) & 3;
                if (c0 >= 0) { NSA_DMA(Kb, (unsigned)(c0 * 8192), nb0, 0); NSA_DMA(Vb, (unsigned)(c0 * 8192), nb0, 1);
                               if (c1 >= 0) { NSA_DMA(Kb, (unsigned)(c1 * 8192), nb1, 0); NSA_DMA(Vb, (unsigned)(c1 * 8192), nb1, 1); } }
                else {
                    NSA_DMA(Kwb, (unsigned)(nlo * 8192), nb0, 0); NSA_DMA(Vwb, (unsigned)(nlo * 8192), nb0, 1); wpre = 1;
                    if (nlo + 1 <= qt) { NSA_DMA(Kwb, (unsigned)((nlo + 1) * 8192), nb1, 0); NSA_DMA(Vwb, (unsigned)((nlo + 1) * 8192), nb1, 1); wpre = 2; }
                }
#pragma unroll 1
                for (int k = 0; k < 2; ++k) {
                    const int n = k ? a1 : a0;
                    if (n < 0) break;
                    const LAS char* kb_ = lds + ((rb + k) & 3) * R_SLOT; const LAS char* vb_ = kb_ + 8192;
                    const bool lsel = (mask >> n) & 1ull;
                    if (__any(lsel)) {
                        const int key0 = 64 * n, tl = t - key0;
                        if (tmin - key0 - 63 >= 790) hot_tile<true, 0>(kb_, vb_, tl, lsel ? cb31 : -INFINITY, rt, qf, ls, o0, o1, r32, hi, lane);
                        else {
                            const LAS float* rtb = lsel ? (rt + 1023 - tl + 4 * hi) : (rt + RT_NEG);
                            if (n == qt) hot_tile<false, 1>(kb_, vb_, tl, 0.f, rtb, qf, ls, o0, o1, r32, hi, lane);
                            else hot_tile<false, 0>(kb_, vb_, tl, 0.f, rtb, qf, ls, o0, o1, r32, hi, lane);
                        }
                    }
                }
                rb = nb0;
                if (c0 < 0) break;
                a0 = c0; a1 = c1;
            }
            sl = rb;
            const float lt = swap_sum(ls); const float sc = lt > 0.f ? gs / lt : 0.f;
#pragma unroll
            for (int r = 0; r < 16; ++r) { ofs[r * 64] += sc * o0[r]; ofs[(16 + r) * 64] += sc * o1[r]; o0[r] = 0.f; o1[r] = 0.f; }
        }
        u32x2 zraw[2][4];
        {
            const bf16_t* zrow_ = prow + C_ZB + head * 64;
#pragma unroll
            for (int mt = 0; mt < 2; ++mt)
#pragma unroll
                for (int r4 = 0; r4 < 4; ++r4) zraw[mt][r4] = *(const u32x2*)(zrow_ + 32 * mt + 8 * r4 + 4 * hi);
            asm volatile("" ::: "memory");
        }
        {
            float lw = 0.f;
            const char* Kb = Kwb; const char* Vb = Vwb;
            int s0 = sl, s1 = NSA_NEXT(sl);
            if (wpre < 1) { NSA_DMA(Kb, (unsigned)(nlo * 8192), s0, 0); NSA_DMA(Vb, (unsigned)(nlo * 8192), s0, 1); }
            if (wpre < 2 && nlo + 1 <= qt) { NSA_DMA(Kb, (unsigned)((nlo + 1) * 8192), s1, 0); NSA_DMA(Vb, (unsigned)((nlo + 1) * 8192), s1, 1); }
            for (int n = nlo; n <= qt; ++n) {
                if (n + 1 <= qt) NSA_WAIT(2); else NSA_WAIT(0);
                NSA_BAR();
                const int s2 = NSA_NEXT(s1);
                if (n + 2 <= qt) { NSA_DMA(Kb, (unsigned)((n + 2) * 8192), s2, 0); NSA_DMA(Vb, (unsigned)((n + 2) * 8192), s2, 1); }
                const LAS char* kb_ = lds + s0 * R_SLOT; const LAS char* vb_ = kb_ + 8192;
                const int key0 = 64 * n, tl = t - key0;
                const LAS float* rtb = rt + 1023 - tl + 4 * hi;
                if (n == qt) hot_tile<false, 1>(kb_, vb_, tl, 0.f, rtb, qf, lw, o0, o1, r32, hi, lane);
                else if (n == qt - 8) hot_tile<false, 2>(kb_, vb_, tl, 0.f, rtb, qf, lw, o0, o1, r32, hi, lane);
                else hot_tile<false, 0>(kb_, vb_, tl, 0.f, rtb, qf, lw, o0, o1, r32, hi, lane);
                s0 = s1; s1 = s2;
            }
            sl = s0;
            const float lt = swap_sum(lw); const float sc = lt > 0.f ? gw / lt : 0.f;
#pragma unroll
            for (int r = 0; r < 16; ++r) { o0[r] = ofs[r * 64] + sc * o0[r]; o1[r] = ofs[(16 + r) * 64] + sc * o1[r]; }
        }
        {
            bf16_t* yrow = p.H + tokrow * DM + 512 + head * 64;
#pragma unroll
            for (int mt = 0; mt < 2; ++mt)
#pragma unroll
                for (int r4 = 0; r4 < 4; ++r4) {
                    const int d = 32 * mt + 8 * r4 + 4 * hi;
                    uint2 zz; zz.x = zraw[mt][r4][0]; zz.y = zraw[mt][r4][1];
                    const float z0 = __uint_as_float(zz.x << 16), z1 = __uint_as_float(zz.x & 0xFFFF0000u), z2 = __uint_as_float(zz.y << 16), z3 = __uint_as_float(zz.y & 0xFFFF0000u);
                    const f32x16& o = mt ? o1 : o0;
                    uint2 y; y.x = pk2(o[4 * r4] * silu(z0), o[4 * r4 + 1] * silu(z1)); y.y = pk2(o[4 * r4 + 2] * silu(z2), o[4 * r4 + 3] * silu(z3));
                    *(uint2*)(yrow + d) = y;
                }
        }
        if (tid == 0) qnx[0] = knext;
        asm volatile("s_waitcnt lgkmcnt(0)" ::: "memory"); __builtin_amdgcn_s_barrier(); asm volatile("" ::: "memory");
        kq_ = __builtin_amdgcn_readfirstlane(qnx[0]);
    }
#undef NSA_DMA
#undef NSA_WAIT
#undef NSA_BAR
#undef NSA_NEXT
}

namespace dsa {
typedef short bf16x8 __attribute__((ext_vector_type(8)));
typedef short s16x4 __attribute__((ext_vector_type(4)));
typedef float f32x4 __attribute__((ext_vector_type(4)));
typedef float f32x16 __attribute__((ext_vector_type(16)));
typedef unsigned u32x4 __attribute__((ext_vector_type(4)));
typedef int i32x4 __attribute__((ext_vector_type(4)));
typedef unsigned u32x2 __attribute__((ext_vector_type(2)));
constexpr int L_SC = 0, L_SEL = 131072, L_LUT = L_SEL + 8192, L_BS = L_LUT + 1024, L_END = L_BS + 1024 + 64, L_QP = L_END;
constexpr int VST = 288;
DEV f32x16 MF32(bf16x8 a, bf16x8 b, f32x16 c) { return __builtin_amdgcn_mfma_f32_32x32x16_bf16(a, b, c, 0, 0, 0); }
DEV f32x4 MF16(bf16x8 a, bf16x8 b, f32x4 c) { return __builtin_amdgcn_mfma_f32_16x16x32_bf16(a, b, c, 0, 0, 0); }
DEV f32x4 MF8(long a, long b, f32x4 c) { return __builtin_amdgcn_mfma_f32_16x16x32_fp8_fp8(a, b, c, 0, 0, 0); }
DEV long pack64(unsigned lo, unsigned hi) { return (long)(((unsigned long long)hi << 32) | (unsigned long long)lo); }
typedef __bf16 bf16x2v __attribute__((ext_vector_type(2)));
DEV unsigned fp8x2_to_bf16x2(unsigned src, bool hiword) { return hiword ? __builtin_bit_cast(unsigned, __builtin_amdgcn_cvt_scalef32_pk_bf16_fp8(src, 1.0f, true)) : __builtin_bit_cast(unsigned, __builtin_amdgcn_cvt_scalef32_pk_bf16_fp8(src, 1.0f, false)); }
DEV int wave_total(int v) {
    v += __builtin_amdgcn_update_dpp(0, v, 0xB1, 0xF, 0xF, true);
    v += __builtin_amdgcn_update_dpp(0, v, 0x4E, 0xF, 0xF, true);
    v += __builtin_amdgcn_update_dpp(0, v, 0x141, 0xF, 0xF, true);
    v += __builtin_amdgcn_update_dpp(0, v, 0x140, 0xF, 0xF, true);
    return __builtin_amdgcn_readlane(v, 0) + __builtin_amdgcn_readlane(v, 16) + __builtin_amdgcn_readlane(v, 32) + __builtin_amdgcn_readlane(v, 48);
}
DEV int wave_incl_scan(int v) {
    int x = v;
    x += __builtin_amdgcn_update_dpp(0, v, 0x111, 0xF, 0xF, true);
    x += __builtin_amdgcn_update_dpp(0, v, 0x112, 0xF, 0xF, true);
    x += __builtin_amdgcn_update_dpp(0, v, 0x113, 0xF, 0xF, true);
    x += __builtin_amdgcn_update_dpp(0, x, 0x114, 0xF, 0xE, true);
    x += __builtin_amdgcn_update_dpp(0, x, 0x118, 0xF, 0xC, true);
    x += __builtin_amdgcn_update_dpp(0, x, 0x142, 0xA, 0xF, true);
    x += __builtin_amdgcn_update_dpp(0, x, 0x143, 0xC, 0xF, true);
    return x;
}
template <int OFF>
DEV void vtr16(const LAS char* const (&ad)[8], s16x4 (&lo)[8], s16x4 (&hi)[8]) {
    long r0, r1, r2, r3, r4, r5, r6, r7, r8, r9, r10, r11, r12, r13, r14, r15;
    asm volatile("ds_read_b64_tr_b16 %0, %16 offset:%24\n\tds_read_b64_tr_b16 %1, %16 offset:%25\n\tds_read_b64_tr_b16 %2, %17 offset:%24\n\tds_read_b64_tr_b16 %3, %17 offset:%25\n\t"
                 "ds_read_b64_tr_b16 %4, %18 offset:%24\n\tds_read_b64_tr_b16 %5, %18 offset:%25\n\tds_read_b64_tr_b16 %6, %19 offset:%24\n\tds_read_b64_tr_b16 %7, %19 offset:%25\n\t"
                 "ds_read_b64_tr_b16 %8, %20 offset:%24\n\tds_read_b64_tr_b16 %9, %20 offset:%25\n\tds_read_b64_tr_b16 %10, %21 offset:%24\n\tds_read_b64_tr_b16 %11, %21 offset:%25\n\t"
                 "ds_read_b64_tr_b16 %12, %22 offset:%24\n\tds_read_b64_tr_b16 %13, %22 offset:%25\n\tds_read_b64_tr_b16 %14, %23 offset:%24\n\tds_read_b64_tr_b16 %15, %23 offset:%25\n\ts_waitcnt lgkmcnt(0)"
                 : "=&v"(r0), "=&v"(r1), "=&v"(r2), "=&v"(r3), "=&v"(r4), "=&v"(r5), "=&v"(r6), "=&v"(r7), "=&v"(r8), "=&v"(r9), "=&v"(r10), "=&v"(r11), "=&v"(r12), "=&v"(r13), "=&v"(r14), "=&v"(r15)
                 : "v"(ad[0]), "v"(ad[1]), "v"(ad[2]), "v"(ad[3]), "v"(ad[4]), "v"(ad[5]), "v"(ad[6]), "v"(ad[7]), "n"(OFF), "n"(OFF + 4096)
                 : "memory");
    lo[0] = __builtin_bit_cast(s16x4, r0); hi[0] = __builtin_bit_cast(s16x4, r1); lo[1] = __builtin_bit_cast(s16x4, r2); hi[1] = __builtin_bit_cast(s16x4, r3);
    lo[2] = __builtin_bit_cast(s16x4, r4); hi[2] = __builtin_bit_cast(s16x4, r5); lo[3] = __builtin_bit_cast(s16x4, r6); hi[3] = __builtin_bit_cast(s16x4, r7);
    lo[4] = __builtin_bit_cast(s16x4, r8); hi[4] = __builtin_bit_cast(s16x4, r9); lo[5] = __builtin_bit_cast(s16x4, r10); hi[5] = __builtin_bit_cast(s16x4, r11);
    lo[6] = __builtin_bit_cast(s16x4, r12); hi[6] = __builtin_bit_cast(s16x4, r13); lo[7] = __builtin_bit_cast(s16x4, r14); hi[7] = __builtin_bit_cast(s16x4, r15);
}
template <int NC>
DEV void bisect256(LAS unsigned* row, int lane, unsigned& T, int& need, LAS int* selw, const LAS unsigned char* lut, int t) {
    u32x4 k[NC];
#pragma unroll
    for (int c = 0; c < NC; ++c) k[c] = *(const LAS u32x4*)(row + 256 * c + 4 * lane);
    unsigned prefix = 0u; bool exact = false;
    int bit = 31, clo = 0, chi = 0, lcnt = 0;
    {
        unsigned mxk = 0u;
#pragma unroll
        for (int c = 0; c < NC; ++c) mxk = max(max(mxk, max(k[c].x, k[c].y)), max(k[c].z, k[c].w));
        mxk = max(mxk, (unsigned)__builtin_amdgcn_update_dpp(0, (int)mxk, 0xB1, 0xF, 0xF, true)); mxk = max(mxk, (unsigned)__builtin_amdgcn_update_dpp(0, (int)mxk, 0x4E, 0xF, 0xF, true));
        mxk = max(mxk, (unsigned)__builtin_amdgcn_update_dpp(0, (int)mxk, 0x141, 0xF, 0xF, true)); mxk = max(mxk, (unsigned)__builtin_amdgcn_update_dpp(0, (int)mxk, 0x140, 0xF, 0xF, true));
        unsigned e9 = max(max((unsigned)__builtin_amdgcn_readlane((int)mxk, 0), (unsigned)__builtin_amdgcn_readlane((int)mxk, 16)), max((unsigned)__builtin_amdgcn_readlane((int)mxk, 32), (unsigned)__builtin_amdgcn_readlane((int)mxk, 48))) >> 23;
        for (int step = 0; step < 6 && e9 > 0u; ++step, --e9) {
            const unsigned cand = e9 << 23;
            int cnt = 0;
#pragma unroll
            for (int c = 0; c < NC; ++c) { cnt += (k[c].x >= cand) ? 1 : 0; cnt += (k[c].y >= cand) ? 1 : 0; cnt += (k[c].z >= cand) ? 1 : 0; cnt += (k[c].w >= cand) ? 1 : 0; }
            const int tot = wave_total(cnt);
            if (tot >= 256) { prefix = cand; bit = 22; exact = (tot == 256); clo = tot; lcnt = cnt; break; }
            chi = tot;
        }
    }
    if (!exact && bit == 22) {
        unsigned lo = prefix, width = 1u << 23;
        int side = 0;
        while (width > 1u) {
            unsigned off = width >> 1;
            if (side > -2 && side < 2) off = (unsigned)((float)width * (((float)clo - 256.5f) * __builtin_amdgcn_rcpf((float)(clo - chi))));
            else side = 0;
            off = min(max(off, 1u), width - 1u);
            const unsigned cand = lo + off;
            int cnt = 0;
#pragma unroll
            for (int c = 0; c < NC; ++c) { cnt += (k[c].x >= cand) ? 1 : 0; cnt += (k[c].y >= cand) ? 1 : 0; cnt += (k[c].z >= cand) ? 1 : 0; cnt += (k[c].w >= cand) ? 1 : 0; }
            const int tot = wave_total(cnt);
            if (tot == 256) { lo = cand; exact = true; lcnt = cnt; break; }
            if (tot > 256) { lo = cand; width -= off; clo = tot; side = side > 0 ? side + 1 : 1; }
            else { width = off; chi = tot; side = side < 0 ? side - 1 : -1; }
        }
        prefix = lo;
        bit = -1;
    }
    if (!exact)
    for (; bit >= 0; --bit) {
        const unsigned cand = prefix | (1u << bit);
        int cnt = 0;
#pragma unroll
        for (int c = 0; c < NC; ++c) { cnt += (k[c].x >= cand) ? 1 : 0; cnt += (k[c].y >= cand) ? 1 : 0; cnt += (k[c].z >= cand) ? 1 : 0; cnt += (k[c].w >= cand) ? 1 : 0; }
        const int tot = wave_total(cnt);
        if (tot >= 256) prefix = cand;
        if (tot == 256) { exact = true; lcnt = cnt; break; }
    }
    if (exact) {
        T = prefix - 1u; need = 0;
        const int cnt = lcnt;
        LAS int* wp = selw + (wave_incl_scan(cnt) - cnt);
        LAS int* const dummy = (LAS int*)row + lane;
        const int i4 = 4 * lane;
#pragma unroll
        for (int c = 0; c < NC; ++c) {
#pragma unroll
            for (int e = 0; e < 4; ++e) {
                const bool f = k[c][e] >= prefix;
                *(f ? wp : dummy) = 256 * c + e + i4;
                wp += f ? 1 : 0;
            }
        }
        int ent[4];
#pragma unroll
        for (int i = 0; i < 4; ++i) ent[i] = selw[lane + 64 * i];
        int bk[4];
#pragma unroll
        for (int i = 0; i < 4; ++i) bk[i] = (int)lut[min(t - ent[i], 1023)];
#pragma unroll
        for (int i = 0; i < 4; ++i) selw[lane + 64 * i] = ent[i] | (bk[i] << 21);
    }
    else {
        int cnt = 0;
#pragma unroll
        for (int c = 0; c < NC; ++c) { cnt += (k[c].x > prefix) ? 1 : 0; cnt += (k[c].y > prefix) ? 1 : 0; cnt += (k[c].z > prefix) ? 1 : 0; cnt += (k[c].w > prefix) ? 1 : 0; }
        T = prefix; need = 256 - wave_total(cnt);
    }
}
}

DEV void phase3_dsa_fast(CP p, int l, int bid, int nb, char* lds_) {
    using namespace dsa;
    using nsa::vtr; using nsa::cvtpk; using nsa::ex2;
    LAS char* lds = (LAS char*)lds_;
    const int tid = tidx(), wid = tid >> 6, lane = tid & 63, r32 = lane & 31, hi = lane >> 5;
    LAS unsigned* sc = (LAS unsigned*)(lds + L_SC);
    LAS int* selw = (LAS int*)(lds + L_SEL) + wid * 256;
    LAS unsigned char* lut = (LAS unsigned char*)(lds + L_LUT);
    LAS float* bs = (LAS float*)(lds + L_BS);
    for (int e = tid; e < 1024; e += NTHREADS) lut[e] = (unsigned char)t5_bucket(e);
    if (tid < 264) bs[tid] = tid < 256 ? p.rel_bias[(tid >> 3) * 16 + (tid & 7)] * nsa::LOG2E - nsa::M0 : -INFINITY;
#define DSA_QPRE(it_) do { const int j_ = (it_) / 256, rem_ = (it_) % 256, b_ = rem_ & 7, a_ = rem_ >> 3; \
        const int tq_ = (j_ & 1) ? 32 * (15 - j_) + a_ : 32 * (15 - j_) + 31 - a_; \
        const bf16_t* src_ = p.P + ((size_t)b_ * SEQ + tq_ * 8 + wid) * PP; \
        __builtin_amdgcn_global_load_lds((const unsigned*)(src_ + C_QI + lane * 8), (LAS unsigned*)(lds + L_QP + wid * 1024), 16, 0, 0); \
          \
        __builtin_amdgcn_global_load_lds((const unsigned*)(src_ + (size_t)(((lane >> 2) & 7) - wid) * PP + C_WI + (lane & 3) * 2), (LAS unsigned*)(lds + L_QP + 8192), 4, 0, 0); } while (0)
    if (bid < NBATCH * 512) DSA_QPRE(bid);
    __syncthreads();
    for (int it = bid; it < NBATCH * 512; it += nb) {
        const int j = it / 256, rem = it % 256, b = rem & 7, a = rem >> 3;
        const int tq = (j & 1) ? 32 * (15 - j) + a : 32 * (15 - j) + 31 - a;
        const int t0 = tq * 8;
        const bf16_t* Pb = p.P + (size_t)b * SEQ * PP;
#ifdef DSA_REP_A
        for (int repA = 0; repA < 2; ++repA)
#endif
        if (t0 + 8 > 256) {
            const int query = 2 * ((r32 >> 2) & 1) + (r32 >> 4), head = 4 * ((r32 >> 3) & 1) + (r32 & 3);
            const LAS char* qp = lds + L_QP;
            bf16x8 aq[2][4];
#pragma unroll
            for (int mt = 0; mt < 2; ++mt)
#pragma unroll
                for (int ks = 0; ks < 4; ++ks) aq[mt][ks] = *(const LAS bf16x8*)(qp + (4 * mt + query) * 1024 + head * 128 + (16 * ks + 8 * hi) * 2);
            float wq[4][8];
#pragma unroll
            for (int qq = 0; qq < 4; ++qq) {
                const u32x4 wr = *(const LAS u32x4*)(qp + 8192 + (4 * (qq >> 1) + 2 * hi + (qq & 1)) * 16);
#pragma unroll
                for (int h = 0; h < 8; ++h) wq[qq][h] = ((h & 1) ? __uint_as_float(wr[h >> 1] & 0xFFFF0000u) : __uint_as_float(wr[h >> 1] << 16)) * (0.35355339059327373f * 0.125f);
            }
            const int NT = (t0 + 7) / 32 + 1;
            LAS unsigned* srow0 = sc + (2 * hi) * 4096 + r32;
            const bf16_t* kbase = p.Ki + (size_t)b * SEQ * 64 + lane * 8;
            for (int g = 0; wid + 32 * g < NT; ++g) {
                bf16x8 bk[4][4];
#pragma unroll
                for (int i = 0; i < 4; ++i) { const int jt = min(wid + 32 * g + 8 * i, NT - 1);
#pragma unroll
                    for (int ks = 0; ks < 4; ++ks) bk[i][ks] = *(const bf16x8*)(kbase + ((size_t)jt * 4 + ks) * 512); }
                asm volatile("" ::: "memory");
#pragma unroll
                for (int i = 0; i < 4; ++i) {
                    const int jt = wid + 32 * g + 8 * i;
                    if (jt >= NT) break;
#pragma unroll
                    for (int mt = 0; mt < 2; ++mt) {
                        f32x16 acc;
#pragma unroll
                        for (int r = 0; r < 16; ++r) acc[r] = 0.f;
#pragma unroll
                        for (int ks = 0; ks < 4; ++ks) acc = MF32(aq[mt][ks], bk[i][ks], acc);
                        float s0 = 0.f, s1 = 0.f;
#pragma unroll
                        for (int h = 0; h < 8; ++h) { s0 = fmaf(wq[2 * mt][h], __int_as_float(max(__float_as_int(acc[h]), 0)), s0); asm("" : "+v"(s0)); s1 = fmaf(wq[2 * mt + 1][h], __int_as_float(max(__float_as_int(acc[8 + h]), 0)), s1); }
                        srow0[(4 * mt) * 4096 + 32 * jt] = f2key(s0); srow0[(4 * mt + 1) * 4096 + 32 * jt] = f2key(s1);
                    }
                }
            }
        }
        __syncthreads();
        const int t = t0 + wid, n = t + 1;
        u32x4 qraw[2]; u32x2 zraw[4]; float4 gqv[2][2];
        {
            const bf16_t* prow_ = Pb + (size_t)t * PP; const int col_ = min(lane & 15, 7), kq_ = lane >> 4;
#pragma unroll
            for (int hh = 0; hh < 2; ++hh) { qraw[hh] = *(const u32x4*)(prow_ + C_QA + col_ * 64 + 16 * kq_ + 8 * hh);
                const float* gq = p.q_norm_a + l * 64 + 16 * kq_ + 8 * hh; gqv[hh][0] = *(const float4*)gq; gqv[hh][1] = *(const float4*)(gq + 4); }
#pragma unroll
            for (int m4 = 0; m4 < 4; ++m4) zraw[m4] = *(const u32x2*)(prow_ + C_ZA + col_ * 64 + 16 * m4 + 4 * kq_);
            asm volatile("" ::: "memory");
        }
        LAS unsigned* row = sc + wid * 4096;
        int nsel;
#ifdef DSA_REP_B
        for (int repB = 0; repB < 2; ++repB)
#endif
        if (n <= 256) { nsel = n; for (int i = lane; i < 256; i += 64) selw[i] = i < n ? (i | ((int)lut[min(t - i, 1023)] << 21)) : (32 << 21); }
        else {
            nsel = 256;
            const int ncls = (n + 511) >> 9;
            const int nrc = ncls << 9;
            for (int i = n + lane; i < nrc; i += 64) row[i] = 0u;
            unsigned T; int need;
            switch (ncls) {
                case 1: bisect256<2>(row, lane, T, need, selw, lut, t); break;
                case 2: bisect256<4>(row, lane, T, need, selw, lut, t); break;
                case 3: bisect256<6>(row, lane, T, need, selw, lut, t); break;
                case 4: bisect256<8>(row, lane, T, need, selw, lut, t); break;
                case 5: bisect256<10>(row, lane, T, need, selw, lut, t); break;
                case 6: bisect256<12>(row, lane, T, need, selw, lut, t); break;
                case 7: bisect256<14>(row, lane, T, need, selw, lut, t); break;
                default: bisect256<16>(row, lane, T, need, selw, lut, t); break;
            }
            int base = 0, eqseen = 0;
            const u64 lt = (lane == 0) ? 0ull : (~0ull >> (64 - lane));
            if (need != 0)
            for (int i0 = 0; i0 < n; i0 += 64) {
                const int i = i0 + lane; const bool v = i < n; const unsigned k = v ? row[i] : 0u;
                const bool gt = v && k > T, eq = v && k == T;
                const u64 beq = __ballot(eq); const int eqrank = eqseen + __popcll(beq & lt);
                const bool take = gt || (eq && eqrank < need);
                const u64 bt = __ballot(take); const int pos = base + __popcll(bt & lt);
                if (take) selw[pos] = i | ((int)lut[min(t - i, 1023)] << 21);
                base += __popcll(bt); eqseen += __popcll(beq);
            }
        }
#ifdef DSA_REP_C
        for (int repC = 0; repC < 2; ++repC)
#endif
        {
            const int col = lane & 15, kq = lane >> 4;
            const bf16_t* prow = Pb + (size_t)t * PP;
            long qb8[4];
#ifndef DSA_REP_C
            if (it + nb < NBATCH * 512) DSA_QPRE(it + nb);
#endif
            const unsigned char* Kab = (const unsigned char*)p.Ka + (size_t)b * SEQ * 128; const unsigned char* Vab = (const unsigned char*)p.Va + (size_t)b * SEQ * 128;
            unsigned Ppk[16][2];
            float sum = 0.f;
            const LAS float* bsh = bs + (col & 7);
            const int wr_r = lane >> 3, wr_c = lane & 7;
            u32x4 vrA[8], vrB[8];
            u32x4 kA[2][2], kB[2][2];
#define DSA_KLOAD(dst, g2_) do { int sk0_ = selw[16 * (2 * (g2_)) + col], sk1_ = selw[16 * (2 * (g2_) + 1) + col]; \
                asm volatile("" : "+v"(sk0_), "+v"(sk1_)); \
                _Pragma("unroll") for (int tt = 0; tt < 2; ++tt) { const int s0_ = (tt ? sk1_ : sk0_) & 0xFFFF; \
                _Pragma("unroll") for (int pp = 0; pp < 2; ++pp) dst[tt][pp] = *(const u32x4*)(Kab + (size_t)s0_ * 128 + 64 * pp + 16 * kq); } } while (0)
#define DSA_KMUL(src, g2_) do { i32x4 svs[2]; svs[0] = *(const LAS i32x4*)(selw + 16 * (2 * (g2_)) + 4 * kq); svs[1] = *(const LAS i32x4*)(selw + 16 * (2 * (g2_) + 1) + 4 * kq);     \
                f32x4 accA[2], accB[2]; \
                _Pragma("unroll") for (int tt = 0; tt < 2; ++tt) { accA[tt] = (f32x4){0.f, 0.f, 0.f, 0.f}; accB[tt] = (f32x4){0.f, 0.f, 0.f, 0.f}; \
                    accA[tt] = MF8(pack64(src[tt][0][0], src[tt][0][1]), qb8[0], accA[tt]); accB[tt] = MF8(pack64(src[tt][1][0], src[tt][1][1]), qb8[2], accB[tt]); \
                    accA[tt] = MF8(pack64(src[tt][0][2], src[tt][0][3]), qb8[1], accA[tt]); accB[tt] = MF8(pack64(src[tt][1][2], src[tt][1][3]), qb8[3], accB[tt]); } \
                float bv_[2][4]; \
                _Pragma("unroll") for (int tt = 0; tt < 2; ++tt) _Pragma("unroll") for (int i = 0; i < 4; ++i) bv_[tt][i] = *(const LAS float*)((const LAS char*)bsh + (svs[tt][i] >> 16)); \
                asm volatile("" : "+v"(bv_[0][0]), "+v"(bv_[0][1]), "+v"(bv_[0][2]), "+v"(bv_[0][3]), "+v"(bv_[1][0]), "+v"(bv_[1][1]), "+v"(bv_[1][2]), "+v"(bv_[1][3])); \
                _Pragma("unroll") for (int tt = 0; tt < 2; ++tt) { const int kt_ = 2 * (g2_) + tt; float e_[4]; \
                    _Pragma("unroll") for (int i = 0; i < 4; ++i) { e_[i] = ex2(fmaf(accA[tt][i] + accB[tt][i], nsa::C2, bv_[tt][i])); sum += e_[i]; } \
                    Ppk[kt_][0] = cvtpk(e_[0], e_[1]); Ppk[kt_][1] = cvtpk(e_[2], e_[3]); } } while (0)
            u32x4 kC[2][2], kD[2][2];
            DSA_KLOAD(kA, 0); DSA_KLOAD(kB, 1); DSA_KLOAD(kC, 2); DSA_KLOAD(kD, 3);
            {
                const bool act = col < 8;
                float xq[2][8]; float ss = 0.f;
#pragma unroll
                for (int hh = 0; hh < 2; ++hh) {
                    uint4 raw = {0u, 0u, 0u, 0u};
                    if (act) { raw.x = qraw[hh][0]; raw.y = qraw[hh][1]; raw.z = qraw[hh][2]; raw.w = qraw[hh][3]; }
                    unpack8g(raw, xq[hh]);
#pragma unroll
                    for (int jx = 0; jx < 8; ++jx) ss = fmaf(xq[hh][jx], xq[hh][jx], ss);
                }
                ss += __shfl_xor(ss, 16); ss += __shfl_xor(ss, 32);
                const float rq = rsqrtf(ss * (1.f / 64.f) + EPS);
#pragma unroll
                for (int ks = 0; ks < 4; ++ks) {
                    const int hh = ks & 1;
                    const float4 g0 = gqv[hh][0], g1 = gqv[hh][1];
                    int w0 = __builtin_amdgcn_cvt_pk_fp8_f32(xq[hh][0] * rq * g0.x, xq[hh][1] * rq * g0.y, 0, false);
                    w0 = __builtin_amdgcn_cvt_pk_fp8_f32(xq[hh][2] * rq * g0.z, xq[hh][3] * rq * g0.w, w0, true);
                    int w1 = __builtin_amdgcn_cvt_pk_fp8_f32(xq[hh][4] * rq * g1.x, xq[hh][5] * rq * g1.y, 0, false);
                    w1 = __builtin_amdgcn_cvt_pk_fp8_f32(xq[hh][6] * rq * g1.z, xq[hh][7] * rq * g1.w, w1, true);
                    qb8[ks] = (act && (ks >> 1) == (col >> 2)) ? pack64((unsigned)w0, (unsigned)w1) : 0l;
                }
            }
            DSA_KMUL(kA, 0); DSA_KLOAD(kA, 4);
            DSA_KMUL(kB, 1); DSA_KLOAD(kB, 5);
            DSA_KMUL(kC, 2); DSA_KLOAD(kC, 6);
            DSA_KMUL(kD, 3); DSA_KLOAD(kD, 7);
#define DSA_VLOAD(dst, u_) do { int sx_[8]; _Pragma("unroll") for (int i = 0; i < 8; ++i) sx_[i] = selw[64 * (u_) + wr_r + 8 * i]; \
                asm volatile("" : "+v"(sx_[0]), "+v"(sx_[1]), "+v"(sx_[2]), "+v"(sx_[3]), "+v"(sx_[4]), "+v"(sx_[5]), "+v"(sx_[6]), "+v"(sx_[7]));     \
                _Pragma("unroll") for (int i = 0; i < 8; ++i) dst[i] = *(const u32x4*)(Vab + (size_t)(sx_[i] & 0xFFFF) * 128 + wr_c * 16); } while (0)
            DSA_KMUL(kA, 4);
            DSA_KMUL(kB, 5); DSA_VLOAD(vrA, 0);
            DSA_KMUL(kC, 6); DSA_VLOAD(vrB, 1);
            DSA_KMUL(kD, 7);
#undef DSA_KLOAD
#undef DSA_KMUL
            sum += __shfl_xor(sum, 16); sum += __shfl_xor(sum, 32);
            const float inv = 1.f / sum;
            f32x4 Og0[4], Og1[4];
#pragma unroll
            for (int mt = 0; mt < 4; ++mt) { Og0[mt] = (f32x4){0.f, 0.f, 0.f, 0.f}; Og1[mt] = (f32x4){0.f, 0.f, 0.f, 0.f}; }
            LAS char* vst = lds + L_SC + wid * 16384;
            const int q4 = (lane & 15) >> 2, p4 = lane & 3;
            const int swz = (4 * (kq & 1) + q4) << 1;
            const LAS char* vrd = vst + (4 * kq + q4) * 256 + (p4 & 1) * 8;
#define DSA_VSTAGE(src) do { _Pragma("unroll") for (int i = 0; i < 8; ++i) { const int rloc = wr_r + 8 * i; \
                _Pragma("unroll") for (int h = 0; h < 2; ++h) { u32x4 w; w.x = fp8x2_to_bf16x2(src[i][2 * h], false); w.y = fp8x2_to_bf16x2(src[i][2 * h], true); w.z = fp8x2_to_bf16x2(src[i][2 * h + 1], false); w.w = fp8x2_to_bf16x2(src[i][2 * h + 1], true); \
                    *(LAS u32x4*)(vst + rloc * 256 + (((2 * wr_c + h) ^ ((rloc & 7) << 1)) << 4)) = w; } \
                if (i & 1) __builtin_amdgcn_sched_barrier(0); } } while (0)
#define DSA_VMUL(u) do { _Pragma("unroll") for (int h2 = 0; h2 < 2; ++h2) { union { unsigned uu[4]; bf16x8 v; } pb; \
                pb.uu[0] = Ppk[4 * (u) + 2 * h2][0]; pb.uu[1] = Ppk[4 * (u) + 2 * h2][1]; pb.uu[2] = Ppk[4 * (u) + 2 * h2 + 1][0]; pb.uu[3] = Ppk[4 * (u) + 2 * h2 + 1][1]; \
                s16x4 tlo[8], thi[8]; if (h2 == 0) vtr16<0>(vad, tlo, thi); else vtr16<8192>(vad, tlo, thi); \
                _Pragma("unroll") for (int mt = 0; mt < 8; ++mt) { \
                    const bf16x8 vf = __builtin_shufflevector(tlo[mt], thi[mt], 0, 1, 2, 3, 4, 5, 6, 7); \
                    if (mt < 4) Og0[mt] = MF16(vf, pb.v, Og0[mt]); else Og1[mt - 4] = MF16(vf, pb.v, Og1[mt - 4]); } } } while (0)
            const LAS char* vad[8];
#pragma unroll
            for (int mt = 0; mt < 8; ++mt) vad[mt] = vrd + (((2 * mt + (p4 >> 1)) ^ swz) << 4);
            DSA_VSTAGE(vrA); DSA_VLOAD(vrA, 2); DSA_VMUL(0);
            DSA_VSTAGE(vrB); DSA_VLOAD(vrB, 3); DSA_VMUL(1);
            DSA_VSTAGE(vrA); DSA_VMUL(2);
            DSA_VSTAGE(vrB); DSA_VMUL(3);
#undef DSA_VLOAD
#undef DSA_VSTAGE
#undef DSA_VMUL
            __builtin_amdgcn_s_waitcnt(0x0F70);
            if (col < 8) {
                const bf16_t* zrow = prow + C_ZA + col * 64; bf16_t* yrow = p.H + (size_t)(b * SEQ + t) * DM + col * 64;
#pragma unroll
                for (int m4 = 0; m4 < 4; ++m4) {
                    const int d = 16 * m4 + 4 * kq;
                    const f32x4 oa = Og0[m4], ob = Og1[m4]; const bool gsel = (col >> 2) != 0;
                    f32x4 o; o[0] = gsel ? ob[0] : oa[0]; o[1] = gsel ? ob[1] : oa[1]; o[2] = gsel ? ob[2] : oa[2]; o[3] = gsel ? ob[3] : oa[3];
                    uint2 zz; zz.x = zraw[m4][0]; zz.y = zraw[m4][1];
                    const float z0 = __uint_as_float(zz.x << 16), z1 = __uint_as_float(zz.x & 0xFFFF0000u), z2 = __uint_as_float(zz.y << 16), z3 = __uint_as_float(zz.y & 0xFFFF0000u);
                    uint2 y; y.x = pk2(o[0] * inv * silu(z0), o[1] * inv * silu(z1)); y.y = pk2(o[2] * inv * silu(z2), o[3] * inv * silu(z3));
                    *(uint2*)(yrow + d) = y;
                }
            }
        }
        asm volatile("s_waitcnt lgkmcnt(0)" ::: "memory"); __builtin_amdgcn_s_barrier(); asm volatile("" ::: "memory");
    }
}


namespace p2 {
typedef short bf16x8 __attribute__((ext_vector_type(8)));
typedef float f32x4 __attribute__((ext_vector_type(4)));
typedef unsigned u32x2 __attribute__((ext_vector_type(2)));
typedef unsigned u32x4 __attribute__((ext_vector_type(4)));
DEV f32x4 MF16(bf16x8 a, bf16x8 b, f32x4 c) { return __builtin_amdgcn_mfma_f32_16x16x32_bf16(a, b, c, 0, 0, 0); }
DEV void unpack8(const uint4 v, float (&x)[8]) {
    x[0] = __uint_as_float(v.x << 16); x[1] = __uint_as_float(v.x & 0xFFFF0000u); x[2] = __uint_as_float(v.y << 16); x[3] = __uint_as_float(v.y & 0xFFFF0000u);
    x[4] = __uint_as_float(v.z << 16); x[5] = __uint_as_float(v.z & 0xFFFF0000u); x[6] = __uint_as_float(v.w << 16); x[7] = __uint_as_float(v.w & 0xFFFF0000u);
}
DEV void norm8(bf16_t* ptr, const float* __restrict__ g, float extra = 1.f) {
    float x[8]; unpack8(*(const uint4*)ptr, x);
    float ss = 0.f;
#pragma unroll
    for (int j = 0; j < 8; ++j) ss = fmaf(x[j], x[j], ss);
    ss += __shfl_xor(ss, 1); ss += __shfl_xor(ss, 2); ss += __shfl_xor(ss, 4);
    const float r = rsqrtf(ss * (1.f / 64.f) + EPS) * extra;
    const float4 g0 = *(const float4*)g, g1 = *(const float4*)(g + 4);
    uint4 o; o.x = pk2(x[0] * r * g0.x, x[1] * r * g0.y); o.y = pk2(x[2] * r * g0.z, x[3] * r * g0.w); o.z = pk2(x[4] * r * g1.x, x[5] * r * g1.y); o.w = pk2(x[6] * r * g1.z, x[7] * r * g1.w);
    *(uint4*)ptr = o;
}
}

DEV void phase2_post_fast(CP p, int l, int bid, int nb, char* lds_) {
    using namespace p2;
    LAS char* lds = (LAS char*)lds_;
    const int tid = tidx(), wid = tid >> 6, lane = tid & 63, col = lane & 15, kq = lane >> 4;
    for (int tt = bid * NWAVES + wid; tt < NTOK / 16; tt += nb * NWAVES) {
        const int tok0 = tt * 16;
        {
            const float gbias = p.b_gate_b[l * 24 + min(lane, 23)];
            unsigned graw[16];
#pragma unroll
            for (int i = 0; i < 16; ++i) graw[i] = (unsigned)(p.P + (size_t)(tok0 + i) * PP)[C_GB + min(lane, 23)];
#pragma unroll
            for (int i = 0; i < 16; ++i) if (lane < 24) (p.P + (size_t)(tok0 + i) * PP)[C_GB + lane] = f2bf(sigmoidf_(__uint_as_float(graw[i] << 16) + gbias));
        }
        bf16x8 af[4]; float4 gna[4];
        {
            const bf16_t* crow = p.P + (size_t)(tok0 + col) * PP + C_CKV + 8 * kq;
            uint4 craw[4]; float4 gkv[4][2];
#pragma unroll
            for (int ks = 0; ks < 4; ++ks) { craw[ks] = *(const uint4*)(crow + 32 * ks); const float* gk = p.kv_norm_a + l * 128 + 32 * ks + 8 * kq; gkv[ks][0] = *(const float4*)gk; gkv[ks][1] = *(const float4*)(gk + 4); }
#pragma unroll
            for (int nt = 0; nt < 4; ++nt) gna[nt] = *(const float4*)(p.k_norm_a + l * 64 + 16 * nt + 4 * kq);
            float x[4][8]; float ss = 0.f;
#pragma unroll
            for (int ks = 0; ks < 4; ++ks) { unpack8(craw[ks], x[ks]);
#pragma unroll
                for (int j = 0; j < 8; ++j) ss = fmaf(x[ks][j], x[ks][j], ss); }
            ss += __shfl_xor(ss, 16); ss += __shfl_xor(ss, 32);
            const float r = rsqrtf(ss * (1.f / 128.f) + EPS);
#pragma unroll
            for (int ks = 0; ks < 4; ++ks) {
                const float gk[8] = {gkv[ks][0].x, gkv[ks][0].y, gkv[ks][0].z, gkv[ks][0].w, gkv[ks][1].x, gkv[ks][1].y, gkv[ks][1].z, gkv[ks][1].w};
                union { unsigned u[4]; bf16x8 v; } pk;
#pragma unroll
                for (int j = 0; j < 4; ++j) pk.u[j] = pk2(x[ks][2 * j] * r * gk[2 * j], x[ks][2 * j + 1] * r * gk[2 * j + 1]);
                af[ks] = pk.v;
            }
        }
        const bf16_t* wkv = p.wt_kvup + (size_t)l * 256 * 128;
#pragma unroll 1
        for (int h4 = 0; h4 < 4; ++h4) {
            f32x4 acc[4];
            bf16x8 wf[4][4];
#pragma unroll
            for (int nt = 0; nt < 4; ++nt)
#pragma unroll
                for (int ks = 0; ks < 4; ++ks) wf[nt][ks] = *(const bf16x8*)(wkv + (size_t)(h4 * 64 + nt * 16 + col) * 128 + 32 * ks + 8 * kq);
            asm volatile("" ::: "memory");
#pragma unroll
            for (int nt = 0; nt < 4; ++nt) {
                acc[nt] = (f32x4){0.f, 0.f, 0.f, 0.f};
#pragma unroll
                for (int ks = 0; ks < 4; ++ks) acc[nt] = MF16(wf[nt][ks], af[ks], acc[nt]);
            }
            float rr = 1.f;
            if (h4 < 2) {
                float s2 = 0.f;
#pragma unroll
                for (int nt = 0; nt < 4; ++nt)
#pragma unroll
                    for (int i = 0; i < 4; ++i) s2 = fmaf(acc[nt][i], acc[nt][i], s2);
                s2 += __shfl_xor(s2, 16); s2 += __shfl_xor(s2, 32);
                rr = rsqrtf(s2 * (1.f / 64.f) + EPS);
            }
            unsigned char* dst = (unsigned char*)(h4 < 2 ? p.Ka : p.Va) + (size_t)(tok0 + col) * 128 + (h4 & 1) * 64 + 4 * kq;
#pragma unroll
            for (int nt = 0; nt < 4; ++nt) {
                float4 gn = {1.f, 1.f, 1.f, 1.f};
                if (h4 < 2) gn = gna[nt];
                int w8 = __builtin_amdgcn_cvt_pk_fp8_f32(acc[nt][0] * rr * gn.x, acc[nt][1] * rr * gn.y, 0, false);
                w8 = __builtin_amdgcn_cvt_pk_fp8_f32(acc[nt][2] * rr * gn.z, acc[nt][3] * rr * gn.w, w8, true);
                *(int*)(dst + 16 * nt) = w8;
            }
        }
    }
    LAS char* h1buf = lds;
    LAS float* ssbuf = (LAS float*)(lds + 4096);
    for (int it = bid; it < NBATCH * 2 * 2 * 8; it += nb) {
        const int rg = it & 7, kv = (it >> 3) & 1, g = (it >> 4) & 1, b = it >> 5;
        const int mtile = wid >> 2, nt = wid & 3;
        const int c = rg * 32 + mtile * 16 + col, cc = min(c, 254);
        const bf16_t* xb = p.P + (size_t)(b * SEQ + 16 * cc) * PP + (kv ? C_VC : C_KC) + g * 64 + 8 * kq;
        const bf16_t* wb = (kv ? p.wt_c1v : p.wt_c1k) + (size_t)l * 64 * 2048 + (size_t)(nt * 16 + col) * 2048 + 8 * kq;
        const float4 cb = *(const float4*)((kv ? p.cbias_v : p.cbias_k) + l * 64 + 16 * nt + 4 * kq);
        const float4 gnc = *(const float4*)(p.k_norm_cmp + l * 64 + 16 * nt + 4 * kq);
        const bf16_t* w2 = (kv ? p.wt_c2v : p.wt_c2k) + (size_t)l * 64 * 64 + (size_t)(16 * nt + col) * 64 + 8 * kq;
        const bf16x8 w2f0 = *(const bf16x8*)(w2), w2f1 = *(const bf16x8*)(w2 + 32);
        f32x4 acc = {0.f, 0.f, 0.f, 0.f};
#pragma unroll 1
        for (int k0 = 0; k0 < 64; k0 += 16) {
            bf16x8 xf[16], wf[16];
#pragma unroll
            for (int j = 0; j < 16; ++j) { const int ks = k0 + j; xf[j] = *(const bf16x8*)(xb + (size_t)(ks >> 1) * PP + 32 * (ks & 1)); wf[j] = *(const bf16x8*)(wb + 32 * ks); }
            asm volatile("" ::: "memory");
#pragma unroll
            for (int j = 0; j < 16; ++j) acc = MF16(wf[j], xf[j], acc);
        }
        {
            u32x2 o; o.x = pk2(gelu_tanh(acc[0] + cb.x), gelu_tanh(acc[1] + cb.y)); o.y = pk2(gelu_tanh(acc[2] + cb.z), gelu_tanh(acc[3] + cb.w));
            *(LAS u32x2*)(h1buf + (mtile * 16 + col) * 128 + (16 * nt + 4 * kq) * 2) = o;
        }
        __syncthreads();
        f32x4 acc2 = {0.f, 0.f, 0.f, 0.f};
#pragma unroll
        for (int s = 0; s < 2; ++s) {
            const bf16x8 hf = *(const LAS bf16x8*)(h1buf + (mtile * 16 + col) * 128 + (32 * s + 8 * kq) * 2);
            acc2 = MF16(s ? w2f1 : w2f0, hf, acc2);
        }
        float rr = 1.f;
        {
            float s2 = (acc2[0] * acc2[0] + acc2[1] * acc2[1]) + (acc2[2] * acc2[2] + acc2[3] * acc2[3]);
            s2 += __shfl_xor(s2, 16); s2 += __shfl_xor(s2, 32);
            if (kq == 0) ssbuf[(mtile * 4 + nt) * 16 + col] = s2;
            __syncthreads();
            const float tot = (ssbuf[(mtile * 4 + 0) * 16 + col] + ssbuf[(mtile * 4 + 1) * 16 + col]) + (ssbuf[(mtile * 4 + 2) * 16 + col] + ssbuf[(mtile * 4 + 3) * 16 + col]);
            if (!kv) rr = rsqrtf(tot * (1.f / 64.f) + EPS);
        }
        {
            float4 gn = {1.f, 1.f, 1.f, 1.f};
            if (!kv) gn = gnc;
            uint2 o; o.x = pk2(acc2[0] * rr * gn.x, acc2[1] * rr * gn.y); o.y = pk2(acc2[2] * rr * gn.z, acc2[3] * rr * gn.w);
            if (c >= 255) { o.x = 0u; o.y = 0u; }
            const int imgc = kv ? ((nt >> 1) * 2048 + (c & 63) * 32 + 16 * (nt & 1) + 4 * kq) : ((2 * nt + (kq >> 1)) * 512 + (c & 63) * 8 + 4 * (kq & 1));
            *(uint2*)((kv ? p.Vc : p.Kc) + (size_t)(b * 2 + g) * 256 * 64 + (size_t)(c >> 6) * 4096 + imgc) = o;
        }
        __syncthreads();
    }
}

constexpr int NPHASES = 1 + 6 + 5;
#ifndef PH_MASK
#define PH_MASK 0xFF
#endif
DEV void run_phase(int ph, int bid, int nb, char* lds, int pass = 0) {
    asm volatile("" : "+s"(bid), "+s"(nb));
    unsigned long long kp = (unsigned long long)__builtin_amdgcn_kernarg_segment_ptr();
    asm volatile("" : "+s"(kp));
    CP p = *(const __attribute__((address_space(4))) Params*)kp;
    if (ph == 0) { if (PH_MASK & 1) phase0_prep(p, bid, nb, lds); return; }
    const int l = (ph - 1) / 6, s = (ph - 1) % 6;
    if (s == 0) { if (PH_MASK & 2) { if (NAIVE_GEMM) phase_gemm_naive<0>(p.H, p.wt_in + (size_t)l * DP * DM, DP, p.P, nullptr, nullptr, bid, nb); else phase_gemm_in(p, l, bid, nb, lds); } }
    else if (s == 1) { if (PH_MASK & 4) { if (NAIVE_P2) phase2_post_naive(p, l, bid, nb, lds); else phase2_post_fast(p, l, bid, nb, lds); } }
    else if (s == 2) {
        if (PH_MASK & 8) { if (NAIVE_DSA) phase3_dsa_naive(p, l, bid, nb, lds); else phase3_dsa_fast(p, l, bid, nb, lds); }
#ifndef SPLIT_ATTN
        __syncthreads();
        if (PH_MASK & 16) { if (NAIVE_NSA) phase3_nsa_naive(p, l, bid, nb, lds); else phase3_nsa_fast(p, l, bid, nb, lds, pass); }
#endif
    }
    else if (s == 3) {
#ifdef SPLIT_ATTN
        if (PH_MASK & 16) { if (NAIVE_NSA) phase3_nsa_naive(p, l, bid, nb, lds); else phase3_nsa_fast(p, l, bid, nb, lds, pass); }
#endif
    }
    else if (s == 4) { if (PH_MASK & 32) { if (NAIVE_GEMM) phase_gemm_naive<1>(p.H, p.wt_out + (size_t)l * DM * DM, DM, nullptr, l == 0 ? p.x : p.out, p.out, bid, nb); else phase_gemm_out(p, l, bid, nb, lds, pass ? p.out2 : p.out); } }
    else { if (PH_MASK & 64) phase_norm_hb(p, 1, bid, nb); }
}


DEV unsigned long long chk_range(const void* base, size_t bytes, int bid, int nb) {
    const uint4* q = (const uint4*)base; const size_t n = bytes / 16; unsigned long long acc = 0ull;
    for (size_t i = (size_t)bid * NTHREADS + tidx(); i < n; i += (size_t)nb * NTHREADS) { const uint4 v = q[i]; acc += (unsigned long long)v.x + ((unsigned long long)v.y << 7) + ((unsigned long long)v.z << 13) + ((unsigned long long)v.w << 19); }
    return acc;
}
DEV void checksum_phase(int ph, int pass, int bid, int nb, float* outp) {
    unsigned long long kp = (unsigned long long)__builtin_amdgcn_kernarg_segment_ptr();
    asm volatile("" : "+s"(kp));
    CP p = *(const __attribute__((address_space(4))) Params*)kp;
    unsigned long long a = 0ull;
    if (ph == 0) {
        a += chk_range(p.H, (size_t)NTOK * DM * 2, bid, nb); a += chk_range(p.wt_in, (size_t)2 * DP * DM * 2, bid, nb); a += chk_range(p.wt_out, (size_t)2 * DM * DM * 2, bid, nb);
        a += chk_range(p.wt_kvup, (size_t)2 * 256 * 128 * 2, bid, nb); a += chk_range(p.wt_c1k, (size_t)2 * 64 * 2048 * 2, bid, nb); a += chk_range(p.wt_c1v, (size_t)2 * 64 * 2048 * 2, bid, nb);
        a += chk_range(p.wt_c2k, (size_t)2 * 64 * 64 * 2, bid, nb); a += chk_range(p.wt_c2v, (size_t)2 * 64 * 64 * 2, bid, nb);
        a += chk_range(p.cbias_k, 2 * 64 * 4, bid, nb); a += chk_range(p.cbias_v, 2 * 64 * 4, bid, nb); a += chk_range(p.biasd, 16 * 1024 * 4, bid, nb);
    } else {
        const int s = (ph - 1) % 6;
        if (s == 0) a += chk_range(p.P, (size_t)NTOK * PP * 2, bid, nb);
        else if (s == 1) { a += chk_range(p.P, (size_t)NTOK * PP * 2, bid, nb); a += chk_range(p.Ka, (size_t)NTOK * 128 * 2, bid, nb); a += chk_range(p.Va, (size_t)NTOK * 128 * 2, bid, nb);
                           a += chk_range(p.Kc, (size_t)NBATCH * 2 * 256 * 64 * 2, bid, nb); a += chk_range(p.Vc, (size_t)NBATCH * 2 * 256 * 64 * 2, bid, nb); }
        else if (s == 2 || s == 3 || s == 5) a += chk_range(p.H, (size_t)NTOK * DM * 2, bid, nb);
        else a += chk_range(outp, (size_t)NTOK * DM * 4, bid, nb);
    }
#pragma unroll
    for (int o = 1; o < 64; o <<= 1) a += __shfl_xor(a, o);
    if ((tidx() & 63) == 0) atomicAdd(p.chk + pass * 16 + ph, a);
}

#define XB_TMO      128
#define XB_XCNT(j)  (256  + 64 * (j))
#define XB_XSUB(j)  (1280 + 64 * (j))
#define XB_XGEN(j)  (2304 + 64 * (j))
#define XB_TOP      3328
#define XB_TOPGEN   3392
#define XCD_BAR_WORDS 3456
static_assert(NSAQ_WORD == XCD_BAR_WORDS + 128, "NSA queue counters must sit in the zeroed spare words of the control block");
#define XB_SPIN_CAP (1u << 20)
DEV unsigned xb_ld(unsigned* p)              { return __hip_atomic_load(p, __ATOMIC_RELAXED, __HIP_MEMORY_SCOPE_AGENT); }
DEV unsigned xb_add(unsigned* p, unsigned v) { return __hip_atomic_fetch_add(p, v, __ATOMIC_RELAXED, __HIP_MEMORY_SCOPE_AGENT); }
DEV unsigned xb_xcc_id() { return (unsigned)__builtin_amdgcn_s_getreg((3 << 11) | 20) & 0xFu; }
#define XB_SPIN(cond, bar) do { unsigned _sp = 0; while (cond) { __builtin_amdgcn_s_sleep(1); \
    if ((++_sp & 255u) == 0u) { if (xb_ld(&(bar)[XB_TMO])) break; if (_sp > XB_SPIN_CAP) { atomicAdd(&(bar)[XB_TMO], 1u); break; } } } } while (0)
struct XcdBarrier { unsigned* bar; unsigned x; volatile __attribute__((address_space(3))) unsigned* st; };
DEV XcdBarrier xcd_barrier_post(unsigned* bar, volatile __attribute__((address_space(3))) unsigned* st) {
    XcdBarrier b; b.bar = bar; b.x = xb_xcc_id(); b.st = st;
    if (tidx() == 0) { const unsigned rk = xb_add(&bar[XB_XCNT(b.x)], 1u); st[2] = rk; st[3] = b.x; }
    return b;
}
DEV void xcd_barrier_complete(unsigned* bar, unsigned x, unsigned& nloc, unsigned& nx) {
    const unsigned G = gridDim.x * gridDim.y * gridDim.z;
    unsigned sum, cnt, mine, sp = 0u;
    for (;;) {
        sum = 0u; cnt = 0u; mine = 0u;
#pragma unroll
        for (unsigned j = 0; j < 16; ++j) { const unsigned c = xb_ld(&bar[XB_XCNT(j)]); sum += c; cnt += (c > 0u) ? 1u : 0u; mine = (j == x) ? c : mine; }
        if (sum == G) break;
        __builtin_amdgcn_s_sleep(1);
        if ((++sp & 255u) == 0u) { if (xb_ld(&bar[XB_TMO])) break; if (sp > XB_SPIN_CAP) { atomicAdd(&bar[XB_TMO], 1u); break; } }
    }
    nloc = mine > 0u ? mine : 1u; nx = cnt > 0u ? cnt : 1u;
}
DEV void xcd_barrier(const XcdBarrier& b) {
    asm volatile("s_waitcnt vmcnt(0)" ::: "memory");
    __syncthreads();
    if (tidx() == 0) {
        unsigned* bar = b.bar;
        __builtin_amdgcn_s_waitcnt(0);
        unsigned nloc = b.st[0], nx = b.st[1];
        if (nloc == 0u) { xcd_barrier_complete(bar, b.x, nloc, nx); b.st[0] = nloc; b.st[1] = nx; }
        const unsigned old = xb_add(&bar[XB_XSUB(b.x)], 1u);
        const unsigned gen = old / nloc;
        if (old + 1u == (gen + 1u) * nloc) {
            __builtin_amdgcn_fence(__ATOMIC_RELEASE, "agent");
            asm volatile("s_waitcnt vmcnt(0)" ::: "memory");
            const unsigned og = xb_add(&bar[XB_TOP], 1u);
            const unsigned tg = og / nx;
            if (og + 1u == (tg + 1u) * nx) xb_add(&bar[XB_TOPGEN], 1u);
            else XB_SPIN(xb_ld(&bar[XB_TOPGEN]) == tg, bar);
            __builtin_amdgcn_fence(__ATOMIC_ACQUIRE, "agent");
            xb_add(&bar[XB_XGEN(b.x)], 1u);
            asm volatile("s_waitcnt vmcnt(0)" ::: "memory");
        } else {
            XB_SPIN(xb_ld(&bar[XB_XGEN(b.x)]) == gen, bar);
            __builtin_amdgcn_fence(__ATOMIC_ACQUIRE, "agent");
            asm volatile("s_waitcnt vmcnt(0)" ::: "memory");
        }
    }
    __syncthreads();
}


DEV void xcd_barrier_light(const XcdBarrier& b) {
    __syncthreads();
    if (tidx() == 0) {
        unsigned* bar = b.bar;
        const unsigned nloc = b.st[0], nx = b.st[1];
        const unsigned old = xb_add(&bar[XB_XSUB(b.x)], 1u);
        const unsigned gen = old / nloc;
        if (old + 1u == (gen + 1u) * nloc) {
            const unsigned og = xb_add(&bar[XB_TOP], 1u);
            const unsigned tg = og / nx;
            if (og + 1u == (tg + 1u) * nx) xb_add(&bar[XB_TOPGEN], 1u);
            else XB_SPIN(xb_ld(&bar[XB_TOPGEN]) == tg, bar);
            xb_add(&bar[XB_XGEN(b.x)], 1u);
        } else {
            XB_SPIN(xb_ld(&bar[XB_XGEN(b.x)]) == gen, bar);
        }
        asm volatile("s_waitcnt vmcnt(0)" ::: "memory");
    }
    __syncthreads();
}

DEV void grid_barrier(cg::grid_group& grid) {
    asm volatile("s_waitcnt vmcnt(0) lgkmcnt(0)" ::: "memory");
    __syncthreads();
    if (tidx() < 64) { __builtin_amdgcn_fence(__ATOMIC_RELEASE, "agent"); asm volatile("s_waitcnt vmcnt(0)" ::: "memory"); }
    __syncthreads();
    grid.sync();
    __builtin_amdgcn_fence(__ATOMIC_ACQUIRE, "agent");
    asm volatile("s_waitcnt vmcnt(0)" ::: "memory");
    __syncthreads();
}

DEV int vbid_for(int ph, int bid, int rank, int x, const XcdBarrier& b, int nb) {
    if (ph == 0) return bid;
    const int s = (ph - 1) % 6;
    if (s != 2 && s != 3) return bid;
    const unsigned nloc = (unsigned)__builtin_amdgcn_readfirstlane((int)b.st[0]), nx = (unsigned)__builtin_amdgcn_readfirstlane((int)b.st[1]);
    const bool balanced = (nx == 8u) && (nloc * 8u == (unsigned)nb) && ((nb & 7) == 0);
    return balanced ? rank * 8 + x : bid;
}

__global__ void __launch_bounds__(NTHREADS) k_fwd(Params p, int ph_lo, int ph_hi) {
    extern __shared__ __attribute__((aligned(16))) char lds[];
    cg::grid_group grid = cg::this_grid();
    volatile __attribute__((address_space(3))) unsigned* st = (volatile __attribute__((address_space(3))) unsigned*)((__attribute__((address_space(3))) char*)lds + LDS_BYTES - 16);
    if (tidx() == 0) { st[0] = 0u; st[1] = 0u; }
    __syncthreads();
    const __attribute__((address_space(4))) Params* barp = (const __attribute__((address_space(4))) Params*)(unsigned long long)__builtin_amdgcn_kernarg_segment_ptr();
    unsigned* barw = barp->ctrl;
    grid.sync();
    XcdBarrier xb = xcd_barrier_post(barw, st);
    __syncthreads();
    const int vb_rank = __builtin_amdgcn_readfirstlane((int)st[2]), vb_x = __builtin_amdgcn_readfirstlane((int)st[3]);
#ifdef SELFCHECK
    for (int pass = 0; pass < 2; ++pass) {
        for (int ph = ph_lo; ph < ph_hi; ++ph) {
            run_phase(ph, blockIdx.x, gridDim.x, lds, pass);
            xcd_barrier(xb); xcd_barrier_light(xb);
            checksum_phase(ph, pass, blockIdx.x, gridDim.x, pass ? barp->out2 : barp->out);
            xcd_barrier(xb); xcd_barrier_light(xb);
        }
    }
    if (blockIdx.x == 0 && tidx() == 0) {
        int f = -1;
        for (int ph = NPHASES - 1; ph >= 0; --ph) if (__hip_atomic_load(barp->chk + ph, __ATOMIC_RELAXED, __HIP_MEMORY_SCOPE_AGENT) != __hip_atomic_load(barp->chk + 16 + ph, __ATOMIC_RELAXED, __HIP_MEMORY_SCOPE_AGENT)) f = ph;
        if (f < 0) { for (int k = 3; k >= 0; --k) if (__hip_atomic_load(barp->chk + 32 + k, __ATOMIC_RELAXED, __HIP_MEMORY_SCOPE_AGENT) != __hip_atomic_load(barp->chk + 40 + k, __ATOMIC_RELAXED, __HIP_MEMORY_SCOPE_AGENT)) f = 12 + k; }
        else { int g2 = -1; for (int k = 3; k >= 0; --k) if (__hip_atomic_load(barp->chk + 32 + k, __ATOMIC_RELAXED, __HIP_MEMORY_SCOPE_AGENT) != __hip_atomic_load(barp->chk + 40 + k, __ATOMIC_RELAXED, __HIP_MEMORY_SCOPE_AGENT)) g2 = k; if (g2 >= 0) f = 12 + g2; }
        if (f >= 0) barp->out[0] = 20.f * (float)(f + 1);
    }
#else
    for (int ph = ph_lo; ph < ph_hi; ++ph) {
#ifndef SPLIT_ATTN
        if (ph > 0 && ((ph - 1) % 6 == 3 || (ph - 1) % 6 == 5)) continue;
#endif
        run_phase(ph, vbid_for(ph, (int)blockIdx.x, vb_rank, vb_x, xb, (int)gridDim.x), gridDim.x, lds);
#ifdef REP_PH
        if (ph == REP_PH) { xcd_barrier(xb); xcd_barrier_light(xb); run_phase(ph, blockIdx.x, gridDim.x, lds); }
#endif
#ifdef REP_BAR
        if (ph == 3) { for (int q = 0; q < REP_BAR; ++q) { xcd_barrier(xb); xcd_barrier_light(xb); } }
#endif
#ifdef REP_S
        if (ph > 0 && (ph - 1) % 6 == REP_S) { xcd_barrier(xb); xcd_barrier_light(xb); run_phase(ph, blockIdx.x, gridDim.x, lds); }
#endif
        if (ph + 1 < ph_hi) { xcd_barrier(xb); xcd_barrier_light(xb); }
    }
#endif
}

extern "C" void kernel_launch(void* const* d_in, const int* in_sizes, int n_in, void* d_out, int out_size, void* d_ws, size_t ws_size, hipStream_t stream) {
    static int grid = 0;
    if (grid == 0) {
        int dev = 0, cus = 0, per_cu = 0;
        hipGetDevice(&dev);
        hipDeviceGetAttribute(&cus, hipDeviceAttributeMultiprocessorCount, dev);
        hipFuncSetAttribute((const void*)k_fwd, hipFuncAttributeMaxDynamicSharedMemorySize, LDS_BYTES);
        hipOccupancyMaxActiveBlocksPerMultiprocessor(&per_cu, (const void*)k_fwd, NTHREADS, LDS_BYTES);
        if (per_cu < 1) { fprintf(stderr, "occupancy query: %d blocks per CU\n", per_cu); per_cu = 1; }
        grid = cus * per_cu;
    }
    Params p{};
    const float** ins = (const float**)&p;
    for (int i = 0; i < 20; ++i) ins[i] = (const float*)d_in[i];
    p.out = (float*)d_out;
    char* w = (char*)d_ws; size_t off = 0;
    auto take = [&](size_t bytes) { char* r = w + off; off += (bytes + 255) & ~(size_t)255; return r; };
    p.ctrl = (unsigned*)take(XCD_BAR_WORDS * 4 + 1024);
    p.chk = (unsigned long long*)(p.ctrl + XCD_BAR_WORDS);
    p.wt_in = (bf16_t*)take((size_t)2 * DP * DM * 2);
    p.wt_out = (bf16_t*)take((size_t)2 * DM * DM * 2);
    p.wt_kvup = (bf16_t*)take((size_t)2 * 256 * 128 * 2);
    p.wt_c1k = (bf16_t*)take((size_t)2 * 64 * 2048 * 2);
    p.wt_c1v = (bf16_t*)take((size_t)2 * 64 * 2048 * 2);
    p.wt_c2k = (bf16_t*)take((size_t)2 * 64 * 64 * 2);
    p.wt_c2v = (bf16_t*)take((size_t)2 * 64 * 64 * 2);
    p.cbias_k = (float*)take(2 * 64 * 4);
    p.cbias_v = (float*)take(2 * 64 * 4);
    p.biasd = (float*)take(16 * 1024 * 4);
    p.H = (bf16_t*)take((size_t)NTOK * DM * 2);
    p.P = (bf16_t*)take((size_t)NTOK * PP * 2);
    p.Ka = (bf16_t*)take((size_t)NTOK * 128 * 2);
    p.Va = (bf16_t*)take((size_t)NTOK * 128 * 2);
    p.Ki = (bf16_t*)take((size_t)NTOK * 64 * 2);
    p.Ks = (bf16_t*)take((size_t)NTOK * 128 * 2); p.Vs = (bf16_t*)take((size_t)NTOK * 128 * 2); p.Kw = (bf16_t*)take((size_t)NTOK * 128 * 2); p.Vw = (bf16_t*)take((size_t)NTOK * 128 * 2);
    p.Kc = (bf16_t*)take((size_t)NBATCH * 2 * 256 * 64 * 2);
    p.Vc = (bf16_t*)take((size_t)NBATCH * 2 * 256 * 64 * 2);
#ifdef SELFCHECK
    p.out2 = (float*)take((size_t)NTOK * DM * 4);
#endif
    p.x1b = (bf16_t*)take((size_t)NTOK * DM * 2);
    p.ssq = (float*)take((size_t)NTOK * 16 * 4);
    p.xb = (bf16_t*)take((size_t)NTOK * DM * 2);
    if (off > ws_size) { fprintf(stderr, "workspace too small: need %zu have %zu\n", off, ws_size); return; }
    hipMemsetAsync(p.ctrl, 0, XCD_BAR_WORDS * 4 + 1024, stream);
#if MEGA
    int lo = 0, hi = NPHASES;
    void* args[] = {&p, &lo, &hi};
    hipError_t e = hipLaunchCooperativeKernel((const void*)k_fwd, dim3(grid), dim3(NTHREADS), args, LDS_BYTES, stream);
    if (e != hipSuccess) fprintf(stderr, "cooperative launch failed: %s (grid %d)\n", hipGetErrorString(e), grid);
#else
    for (int ph = 0; ph < NPHASES; ++ph) hipLaunchKernelGGL(k_fwd, dim3(grid), dim3(NTHREADS), LDS_BYTES, stream, p, ph, ph + 1);
#endif
}
```
